# Optimizing an MI355X kernel written in HIP

```python
import math, functools
import jax, jax.numpy as jnp
from jax import lax
import numpy as np

D_MODEL = 1024
BATCH = 8
SEQ = 2048
DEPTH = 2

GRID_W = 64
CTX_LEN = 256
N_EVEN = (DEPTH + 1) // 2
N_ODD = DEPTH // 2
D_FF = 2816
FFN_RES = 0.5
N_MOD = 9
EPS = 1e-6
ROPE_THETA = 10000.0
Q_BLOCK = 128
CHUNK = 64

MLA_HEADS = 8
MLA_NOPE = 64
MLA_ROPE = 32
MLA_QK = MLA_NOPE + MLA_ROPE
MLA_V = 64
MLA_Q_RANK = 384
MLA_KV_RANK = 256
MLA_VW = MLA_HEADS * MLA_V

GDN_HEADS = 8
GDN_DK = 64
GDN_DV = 64
GDN_CONV = 5
GDN_QK = GDN_HEADS * GDN_DK
GDN_VW = GDN_HEADS * GDN_DV

GLA_HEADS = 4
GLA_DK = 64
GLA_DV = 128
GLA_RANK = 16
GLA_TAU = 16.0
GLA_QK = GLA_HEADS * GLA_DK
GLA_VW = GLA_HEADS * GLA_DV

SWA_HEADS = 8
SWA_KV_HEADS = 2
SWA_DH = 64
SWA_WINDOW = 128
SWA_QW = SWA_HEADS * SWA_DH
SWA_KW = SWA_KV_HEADS * SWA_DH

EVEN_SPLITS = (MLA_Q_RANK, MLA_KV_RANK, MLA_ROPE, GDN_QK, GDN_QK, GDN_VW,
               GDN_HEADS, GDN_HEADS, GDN_HEADS, GDN_HEADS, GDN_VW)
ODD_SPLITS = (GLA_QK, GLA_QK, GLA_VW, GLA_RANK, GLA_RANK, GLA_VW, SWA_QW, SWA_KW, SWA_KW)
EVEN_IN = sum(EVEN_SPLITS)
ODD_IN = sum(ODD_SPLITS)
MIX_EVEN = MLA_VW + GDN_VW
MIX_ODD = GLA_VW + SWA_QW

F32 = jnp.float32

kernel_name = 'hybrid_mla_gdn_gla_swa_prefix_block'


def rms_norm(x, g):
    x32 = x.astype(F32)
    y = x32 * lax.rsqrt(jnp.mean(x32 * x32, axis=-1, keepdims=True) + EPS)
    return (y * g.astype(F32)).astype(x.dtype)


def l2_norm(x):
    x32 = x.astype(F32)
    return (x32 * lax.rsqrt(jnp.sum(x32 * x32, axis=-1, keepdims=True) + EPS)).astype(x.dtype)


def modulate(h, shift, scale):
    return h * (1 + scale) + shift


def split_cols(z, sizes):
    return jnp.split(z, [int(s) for s in np.cumsum(sizes)[:-1]], axis=-1)


def swiglu(h, w_gate, w_up, w_down):
    return (jax.nn.silu(h @ w_gate) * (h @ w_up)) @ w_down


def ffn_half_step(x, g, shift, scale, gate, w_gate, w_up, w_down):
    h = modulate(rms_norm(x, g), shift, scale)
    return x + FFN_RES * gate * swiglu(h, w_gate, w_up, w_down)


def axial_rope_tables(rows, rot_dim):
    t = jnp.arange(rows * GRID_W)
    row = (t // GRID_W).astype(F32)
    col = (t % GRID_W).astype(F32)
    n_freq = rot_dim // 4
    inv = ROPE_THETA ** (-jnp.arange(n_freq, dtype=F32) / n_freq)
    ang = jnp.concatenate([row[:, None] * inv, col[:, None] * inv], axis=-1)
    return jnp.cos(ang), jnp.sin(ang)


def apply_rope(x, cos, sin):
    x1, x2 = jnp.split(x.astype(F32), 2, axis=-1)
    c, s = cos[None, :, None, :], sin[None, :, None, :]
    return jnp.concatenate([x1 * c - x2 * s, x1 * s + x2 * c], axis=-1).astype(x.dtype)


def centred_depthwise_conv(x, w):
    k_w, ch = w.shape
    return lax.conv_general_dilated(x, w[:, None, :].astype(x.dtype), window_strides=(1,),
                                    padding=[(k_w // 2, k_w // 2)],
                                    dimension_numbers=('NWC', 'WIO', 'NWC'),
                                    feature_group_count=ch)


def dense_attention(q, k, v, scale):
    b, n, h, dq = q.shape
    nb = n // Q_BLOCK
    qb = jnp.moveaxis(q.reshape(b, nb, Q_BLOCK, h, dq), 1, 0)

    def block(qi):
        s = jnp.einsum('bqhd,bkhd->bhqk', qi, k, preferred_element_type=F32) * scale
        p = jax.nn.softmax(s, axis=-1).astype(v.dtype)
        return jnp.einsum('bhqk,bkhd->bqhd', p, v, preferred_element_type=F32).astype(q.dtype)

    o = lax.map(block, qb)
    return jnp.moveaxis(o, 0, 1).reshape(b, n, h, v.shape[-1])


def sink_attention(q, k, v, sink, scale):
    b, n, h, dh = q.shape
    g = k.shape[2]
    r = h // g
    qg = q.reshape(b, n, g, r, dh)
    s = jnp.einsum('bqgrd,bkgd->bgrqk', qg, k, preferred_element_type=F32) * scale
    s_sink = jnp.broadcast_to(sink.astype(F32).reshape(1, g, r, 1, 1), s.shape[:-1] + (1,))
    p = jax.nn.softmax(jnp.concatenate([s, s_sink], axis=-1), axis=-1)[..., :-1].astype(v.dtype)
    o = jnp.einsum('bgrqk,bkgd->bqgrd', p, v, preferred_element_type=F32)
    return o.reshape(b, n, h, dh).astype(q.dtype)


def banded_window_attention(q, k, v, k_ctx, v_ctx, sink, scale):
    b, n, h, dh = q.shape
    g = k.shape[2]
    r = h // g
    w = SWA_WINDOW
    nb = n // w
    qb = q.reshape(b, nb, w, g, r, dh)

    def band(t):
        tp = jnp.pad(t, ((0, 0), (w, w), (0, 0), (0, 0))).reshape(b, nb + 2, w, g, dh)
        return jnp.concatenate([tp[:, :-2], tp[:, 1:-1], tp[:, 2:]], axis=2)

    kb, vb = band(k), band(v)
    s_band = jnp.einsum('bnqgrd,bnkgd->bngrqk', qb, kb, preferred_element_type=F32) * scale
    s_ctx = jnp.einsum('bnqgrd,bcgd->bngrqc', qb, k_ctx, preferred_element_type=F32) * scale
    qi = jnp.arange(w)[:, None]
    kr = jnp.arange(3 * w)[None, :]
    kpos = jnp.arange(nb)[:, None, None] * w - w + kr
    rel = kr - qi
    valid = (rel >= 0) & (rel <= 2 * w) & (kpos >= 0) & (kpos < n)
    s_band = jnp.where(valid[None, :, None, None], s_band, -jnp.inf)
    s_sink = jnp.broadcast_to(sink.astype(F32).reshape(1, 1, g, r, 1, 1), s_band.shape[:-1] + (1,))
    p = jax.nn.softmax(jnp.concatenate([s_band, s_ctx, s_sink], axis=-1), axis=-1).astype(v.dtype)
    n_band = 3 * w
    o = (jnp.einsum('bngrqk,bnkgd->bnqgrd', p[..., :n_band], vb, preferred_element_type=F32)
         + jnp.einsum('bngrqc,bcgd->bnqgrd', p[..., n_band:n_band + k_ctx.shape[1]], v_ctx,
                      preferred_element_type=F32))
    return o.reshape(b, n, h, dh).astype(q.dtype)


def to_chunks(t):
    b, n, h = t.shape[:3]
    t = t.reshape(b, n // CHUNK, CHUNK, h, *t.shape[3:])
    return jnp.moveaxis(t, (1, 3), (0, 2))


def from_chunks(t):
    t = jnp.moveaxis(t, (0, 2), (1, 3))
    return t.reshape(t.shape[0], t.shape[1] * t.shape[2], t.shape[3], t.shape[4])


def gated_delta_chunked(q, k, v, g, beta, s0):
    dt = v.dtype
    q, k, v, g, beta = (to_chunks(t.astype(F32)) for t in (q, k, v, g, beta))
    gc = jnp.cumsum(g, axis=-1)
    idx = jnp.arange(CHUNK)
    incl = idx[:, None] >= idx[None, :]
    strict = idx[:, None] > idx[None, :]
    decay = jnp.exp(jnp.where(incl, gc[..., :, None] - gc[..., None, :], -jnp.inf))
    a = jnp.where(strict, beta[..., :, None] * jnp.einsum('nbhid,nbhjd->nbhij', k, k) * decay, 0.0)
    t_mat = a + jnp.eye(CHUNK, dtype=F32)
    solve = functools.partial(lax.linalg.triangular_solve, left_side=True, lower=True, unit_diagonal=True)
    u = solve(t_mat, v * beta[..., None])
    w = solve(t_mat, k * (beta * jnp.exp(gc))[..., None])
    qk = jnp.einsum('nbhid,nbhjd->nbhij', q, k) * decay
    q_dec = q * jnp.exp(gc)[..., None]
    k_dec = k * jnp.exp(gc[..., -1:] - gc)[..., None]
    g_last = jnp.exp(gc[..., -1])

    def step(s, xs):
        u_i, w_i, qk_i, qd_i, kd_i, gl_i = xs
        v_new = u_i - jnp.einsum('bhcd,bhde->bhce', w_i, s)
        o = jnp.einsum('bhcd,bhde->bhce', qd_i, s) + jnp.einsum('bhij,bhje->bhie', qk_i, v_new)
        s = s * gl_i[..., None, None] + jnp.einsum('bhcd,bhce->bhde', kd_i, v_new)
        return s, o

    s_fin, o = lax.scan(step, s0, (u, w, qk, q_dec, k_dec, g_last))
    return from_chunks(o).astype(dt), s_fin


def gla_chunked(q, k, v, log_a, s0):
    dt = v.dtype
    q, k, v, log_a = (to_chunks(t.astype(F32)) for t in (q, k, v, log_a))
    bc = jnp.cumsum(log_a, axis=-2)
    idx = jnp.arange(CHUNK)
    incl = idx[:, None] >= idx[None, :]
    q_dec = q * jnp.exp(bc)
    attn = jnp.where(incl, jnp.einsum('nbhid,nbhjd->nbhij', q_dec, k * jnp.exp(-bc)), 0.0)
    o_intra = jnp.einsum('nbhij,nbhje->nbhie', attn, v)
    b_last = bc[..., -1, :]
    k_dec = k * jnp.exp(b_last[..., None, :] - bc)

    def step(s, xs):
        qd_i, kd_i, v_i, bl_i = xs
        o = jnp.einsum('bhcd,bhde->bhce', qd_i, s)
        s = s * jnp.exp(bl_i)[..., :, None] + jnp.einsum('bhcd,bhce->bhde', kd_i, v_i)
        return s, o

    s_fin, o_inter = lax.scan(step, s0, (q_dec, k_dec, v, b_last))
    return from_chunks(o_intra + o_inter).astype(dt), s_fin


def bidir_prefix_scan(scan_fn, ctx_f, lat_f, ctx_b, lat_b, s0, ctx_out):
    flip = lambda t: jnp.flip(t, axis=1)
    oc_f, sc_f = scan_fn(*ctx_f, s0)
    ol_f, _ = scan_fn(*lat_f, sc_f)
    oc_b, sc_b = scan_fn(*[flip(t) for t in ctx_b], s0)
    ol_b, _ = scan_fn(*[flip(t) for t in lat_b], sc_b)
    o_lat = ol_f + flip(ol_b)
    o_ctx = oc_f + flip(oc_b) if ctx_out else None
    return o_lat, o_ctx


def mla_gdn_mixer(xn, hn, w_in, q_a_norm, w_q_up, kv_a_norm, w_kv_up, q_norm, k_norm,
                  conv_w, a_log, dt_bias, out_norm, w_out, rope, ctx_out):
    b = xn.shape[0]
    zx = split_cols(xn @ w_in, EVEN_SPLITS)
    zh = split_cols(hn @ w_in, EVEN_SPLITS)

    def mla_proj(z, rope_tab):
        cq, ckv, kr = z[0], z[1], z[2]
        n = cq.shape[1]
        q = (rms_norm(cq, q_a_norm) @ w_q_up).reshape(b, n, MLA_HEADS, MLA_QK)
        kv = (rms_norm(ckv, kv_a_norm) @ w_kv_up).reshape(b, n, MLA_HEADS, MLA_NOPE + MLA_V)
        k_nope, v = kv[..., :MLA_NOPE], kv[..., MLA_NOPE:]
        k = jnp.concatenate([k_nope, jnp.broadcast_to(kr[:, :, None, :], (b, n, MLA_HEADS, MLA_ROPE))], axis=-1)
        q, k = rms_norm(q, q_norm), rms_norm(k, k_norm)
        if rope_tab is not None:
            q = jnp.concatenate([q[..., :MLA_NOPE], apply_rope(q[..., MLA_NOPE:], *rope_tab)], axis=-1)
            k = jnp.concatenate([k[..., :MLA_NOPE], apply_rope(k[..., MLA_NOPE:], *rope_tab)], axis=-1)
        return q, k, v

    qx, kx, vx = mla_proj(zx, rope)
    qh, kh, vh = mla_proj(zh, None)
    scale = MLA_QK ** -0.5
    o_mla_x = dense_attention(qx, jnp.concatenate([kx, kh], axis=1), jnp.concatenate([vx, vh], axis=1), scale)

    def gdn_inputs(z):
        qkv = jax.nn.silu(centred_depthwise_conv(jnp.concatenate(z[3:6], axis=-1), conv_w))
        q, k, v = split_cols(qkv, (GDN_QK, GDN_QK, GDN_VW))
        n = q.shape[1]
        q = l2_norm(q.reshape(b, n, GDN_HEADS, GDN_DK)) * GDN_DK ** -0.5
        k = l2_norm(k.reshape(b, n, GDN_HEADS, GDN_DK))
        v = v.reshape(b, n, GDN_HEADS, GDN_DV)
        dirs = []
        for d in range(2):
            g = -jnp.exp(a_log[d].astype(F32)) * jax.nn.softplus(z[6 + d].astype(F32) + dt_bias[d].astype(F32))
            beta = jax.nn.sigmoid(z[8 + d].astype(F32))
            dirs.append((q, k, v, g, beta))
        return dirs

    lat_f, lat_b = gdn_inputs(zx)
    ctx_f, ctx_b = gdn_inputs(zh)
    s0 = jnp.zeros((b, GDN_HEADS, GDN_DK, GDN_DV), F32)
    o_gdn_x, o_gdn_h = bidir_prefix_scan(gated_delta_chunked, ctx_f, lat_f, ctx_b, lat_b, s0, ctx_out)

    def gdn_out(o, zg):
        n = o.shape[1]
        return (rms_norm(o, out_norm) * jax.nn.silu(zg.reshape(b, n, GDN_HEADS, GDN_DV))).reshape(b, n, GDN_VW)

    n_lat = xn.shape[1]
    ox = jnp.concatenate([o_mla_x.reshape(b, n_lat, MLA_VW), gdn_out(o_gdn_x, zx[10])], axis=-1) @ w_out
    if not ctx_out:
        return ox, None
    o_mla_h = dense_attention(qh, kh, vh, scale)
    n_ctx = hn.shape[1]
    oh = jnp.concatenate([o_mla_h.reshape(b, n_ctx, MLA_VW), gdn_out(o_gdn_h, zh[10])], axis=-1) @ w_out
    return ox, oh


def gla_swa_mixer(xn, hn, w_in, gate_w2, gate_b, gla_out_norm, q_norm, k_norm, sink, w_out, rope, ctx_out):
    b = xn.shape[0]
    zx = split_cols(xn @ w_in, ODD_SPLITS)
    zh = split_cols(hn @ w_in, ODD_SPLITS)

    def gla_inputs(z):
        n = z[0].shape[1]
        q = z[0].reshape(b, n, GLA_HEADS, GLA_DK) * GLA_DK ** -0.5
        k = z[1].reshape(b, n, GLA_HEADS, GLA_DK)
        v = z[2].reshape(b, n, GLA_HEADS, GLA_DV)
        dirs = []
        for d in range(2):
            logit = z[3 + d] @ gate_w2[d] + gate_b[d]
            log_a = jax.nn.log_sigmoid(logit.astype(F32)) / GLA_TAU
            dirs.append((q, k, v, log_a.reshape(b, n, GLA_HEADS, GLA_DK)))
        return dirs

    lat_f, lat_b = gla_inputs(zx)
    ctx_f, ctx_b = gla_inputs(zh)
    s0 = jnp.zeros((b, GLA_HEADS, GLA_DK, GLA_DV), F32)
    o_gla_x, o_gla_h = bidir_prefix_scan(gla_chunked, ctx_f, lat_f, ctx_b, lat_b, s0, ctx_out)

    def gla_out(o, r):
        n = o.shape[1]
        return (rms_norm(o, gla_out_norm) * jax.nn.silu(r.reshape(b, n, GLA_HEADS, GLA_DV))).reshape(b, n, GLA_VW)

    def swa_proj(z, rope_tab):
        n = z[6].shape[1]
        q = rms_norm(z[6].reshape(b, n, SWA_HEADS, SWA_DH), q_norm)
        k = rms_norm(z[7].reshape(b, n, SWA_KV_HEADS, SWA_DH), k_norm)
        v = z[8].reshape(b, n, SWA_KV_HEADS, SWA_DH)
        if rope_tab is not None:
            q, k = apply_rope(q, *rope_tab), apply_rope(k, *rope_tab)
        return q, k, v

    qx, kx, vx = swa_proj(zx, rope)
    qh, kh, vh = swa_proj(zh, None)
    scale = SWA_DH ** -0.5
    o_swa_x = banded_window_attention(qx, kx, vx, kh, vh, sink, scale)
    n_lat = xn.shape[1]
    ox = jnp.concatenate([gla_out(o_gla_x, zx[5]), o_swa_x.reshape(b, n_lat, SWA_QW)], axis=-1) @ w_out
    if not ctx_out:
        return ox, None
    o_swa_h = sink_attention(qh, kh, vh, sink, scale)
    n_ctx = hn.shape[1]
    oh = jnp.concatenate([gla_out(o_gla_h, zh[5]), o_swa_h.reshape(b, n_ctx, SWA_QW)], axis=-1) @ w_out
    return ox, oh


def setup_inputs(seed: int = 0) -> dict:
    key = jax.random.key(seed)
    keys = iter(jax.random.split(key, 32))

    def normal(shape, std):
        return jax.random.normal(next(keys), shape, F32) * std

    def gain(shape):
        return 1.0 + 0.05 * jax.random.normal(next(keys), shape, F32)

    d = D_MODEL
    ne, no = N_EVEN, N_ODD
    x = normal((BATCH, SEQ, d), 1.0)
    c = normal((BATCH, d), 1.0)
    ctx = normal((BATCH, CTX_LEN, d), 1.0)
    c_ctx = normal((d,), 1.0)
    ada_w = normal((DEPTH, d, N_MOD * d), 0.5 * d ** -0.5)
    ada_b = normal((DEPTH, N_MOD * d), 0.02)
    norm_g = gain((DEPTH, 3, d))
    ffn_w_gate = normal((DEPTH, 2, d, D_FF), d ** -0.5)
    ffn_w_up = normal((DEPTH, 2, d, D_FF), d ** -0.5)
    ffn_w_down = normal((DEPTH, 2, D_FF, d), D_FF ** -0.5)
    ev_w_in = normal((ne, d, EVEN_IN), d ** -0.5)
    ev_q_a_norm = gain((ne, MLA_Q_RANK))
    ev_w_q_up = normal((ne, MLA_Q_RANK, MLA_HEADS * MLA_QK), MLA_Q_RANK ** -0.5)
    ev_kv_a_norm = gain((ne, MLA_KV_RANK))
    ev_w_kv_up = normal((ne, MLA_KV_RANK, MLA_HEADS * (MLA_NOPE + MLA_V)), MLA_KV_RANK ** -0.5)
    ev_mla_q_norm = gain((ne, MLA_QK))
    ev_mla_k_norm = gain((ne, MLA_QK))
    ev_gdn_conv = normal((ne, GDN_CONV, 2 * GDN_QK + GDN_VW), GDN_CONV ** -0.5)
    ev_gdn_a_log = jnp.log(jax.random.uniform(next(keys), (ne, 2, GDN_HEADS), F32, 1.0, 16.0))
    dt = jnp.exp(jax.random.uniform(next(keys), (ne, 2, GDN_HEADS), F32, math.log(1e-3), math.log(1e-1)))
    ev_gdn_dt_bias = dt + jnp.log(-jnp.expm1(-dt))
    ev_gdn_out_norm = gain((ne, GDN_DV))
    ev_w_out = normal((ne, MIX_EVEN, d), MIX_EVEN ** -0.5)
    od_w_in = normal((no, d, ODD_IN), d ** -0.5)
    od_gla_gate_w2 = normal((no, 2, GLA_RANK, GLA_QK), GLA_RANK ** -0.5)
    od_gla_gate_b = normal((no, 2, GLA_QK), 0.1)
    od_gla_out_norm = gain((no, GLA_DV))
    od_swa_q_norm = gain((no, SWA_DH))
    od_swa_k_norm = gain((no, SWA_DH))
    od_swa_sink = normal((no, SWA_HEADS), 0.5)
    od_w_out = normal((no, MIX_ODD, d), MIX_ODD ** -0.5)
    return {
        'x': x, 'c': c, 'ctx': ctx, 'c_ctx': c_ctx,
        'ada_w': ada_w, 'ada_b': ada_b, 'norm_g': norm_g,
        'ffn_w_gate': ffn_w_gate, 'ffn_w_up': ffn_w_up, 'ffn_w_down': ffn_w_down,
        'ev_w_in': ev_w_in, 'ev_q_a_norm': ev_q_a_norm, 'ev_w_q_up': ev_w_q_up,
        'ev_kv_a_norm': ev_kv_a_norm, 'ev_w_kv_up': ev_w_kv_up,
        'ev_mla_q_norm': ev_mla_q_norm, 'ev_mla_k_norm': ev_mla_k_norm,
        'ev_gdn_conv': ev_gdn_conv, 'ev_gdn_a_log': ev_gdn_a_log, 'ev_gdn_dt_bias': ev_gdn_dt_bias,
        'ev_gdn_out_norm': ev_gdn_out_norm, 'ev_w_out': ev_w_out,
        'od_w_in': od_w_in, 'od_gla_gate_w2': od_gla_gate_w2, 'od_gla_gate_b': od_gla_gate_b,
        'od_gla_out_norm': od_gla_out_norm, 'od_swa_q_norm': od_swa_q_norm, 'od_swa_k_norm': od_swa_k_norm,
        'od_swa_sink': od_swa_sink, 'od_w_out': od_w_out,
    }


def reference(x, c, ctx, c_ctx, ada_w, ada_b, norm_g, ffn_w_gate, ffn_w_up, ffn_w_down,
              ev_w_in, ev_q_a_norm, ev_w_q_up, ev_kv_a_norm, ev_w_kv_up, ev_mla_q_norm, ev_mla_k_norm,
              ev_gdn_conv, ev_gdn_a_log, ev_gdn_dt_bias, ev_gdn_out_norm, ev_w_out,
              od_w_in, od_gla_gate_w2, od_gla_gate_b, od_gla_out_norm, od_swa_q_norm, od_swa_k_norm,
              od_swa_sink, od_w_out):
    ROWS = x.shape[1] // GRID_W
    rope_mla = axial_rope_tables(ROWS, MLA_ROPE)
    rope_swa = axial_rope_tables(ROWS, SWA_DH)
    h = ctx
    sc = jax.nn.silu(c)
    scc = jax.nn.silu(c_ctx)
    for i in range(DEPTH):
        ctx_out = i < DEPTH - 1
        mx = jnp.split((sc @ ada_w[i] + ada_b[i])[:, None, :], N_MOD, axis=-1)
        mh = jnp.split((scc @ ada_w[i] + ada_b[i])[None, None, :], N_MOD, axis=-1)
        x = ffn_half_step(x, norm_g[i, 0], mx[0], mx[1], mx[2], ffn_w_gate[i, 0], ffn_w_up[i, 0], ffn_w_down[i, 0])
        h = ffn_half_step(h, norm_g[i, 0], mh[0], mh[1], mh[2], ffn_w_gate[i, 0], ffn_w_up[i, 0], ffn_w_down[i, 0])
        xn = modulate(rms_norm(x, norm_g[i, 1]), mx[3], mx[4])
        hn = modulate(rms_norm(h, norm_g[i, 1]), mh[3], mh[4])
        j = i // 2
        if i % 2 == 0:
            ox, oh = mla_gdn_mixer(xn, hn, ev_w_in[j], ev_q_a_norm[j], ev_w_q_up[j], ev_kv_a_norm[j],
                                   ev_w_kv_up[j], ev_mla_q_norm[j], ev_mla_k_norm[j], ev_gdn_conv[j],
                                   ev_gdn_a_log[j], ev_gdn_dt_bias[j], ev_gdn_out_norm[j], ev_w_out[j],
                                   rope_mla, ctx_out)
        else:
            ox, oh = gla_swa_mixer(xn, hn, od_w_in[j], od_gla_gate_w2[j], od_gla_gate_b[j], od_gla_out_norm[j],
                                   od_swa_q_norm[j], od_swa_k_norm[j], od_swa_sink[j], od_w_out[j],
                                   rope_swa, ctx_out)
        x = x + mx[5] * ox
        x = ffn_half_step(x, norm_g[i, 2], mx[6], mx[7], mx[8], ffn_w_gate[i, 1], ffn_w_up[i, 1], ffn_w_down[i, 1])
        if ctx_out:
            h = h + mh[5] * oh
            h = ffn_half_step(h, norm_g[i, 2], mh[6], mh[7], mh[8], ffn_w_gate[i, 1], ffn_w_up[i, 1], ffn_w_down[i, 1])
    return x
```

```cpp
#include <hip/hip_runtime.h>
#include <hip/hip_cooperative_groups.h>
#include <cstdio>
namespace cg = cooperative_groups;

#define DI __device__ __forceinline__
typedef unsigned short u16;
typedef short bf16x8 __attribute__((ext_vector_type(8)));
typedef float f32x16 __attribute__((ext_vector_type(16)));
typedef unsigned u32x4 __attribute__((ext_vector_type(4)));
typedef float f32x2 __attribute__((ext_vector_type(2)));
typedef float f32x4v __attribute__((ext_vector_type(4)));
#define LAS3 __attribute__((address_space(3)))
#define MFMA(a, b, c) __builtin_amdgcn_mfma_f32_32x32x16_bf16((a), (b), (c), 0, 0, 0)

constexpr int D = 1024, NB = 8, SEQ = 2048, CTXL = 256;
constexpr int LAT = NB * SEQ, NCTX = NB * CTXL, T = LAT + NCTX;
constexpr int DFF = 2816;
constexpr int EVEN_IN = 2752, EVEN_PAD = 2816, ODD_IN = 2336, ODD_PAD = 2432;
constexpr float EPS = 1e-6f;
constexpr float LOG2E = 1.4426950408889634f;
constexpr int NTHR = 256;
constexpr int SMEM_BYTES = 81920;

constexpr size_t OFF_WGU = 0;
constexpr size_t OFF_WDN = OFF_WGU + 2ull * 5632 * 1024 * 2;
constexpr size_t OFF_WIN = OFF_WDN + 2ull * 1024 * 2816 * 2;
constexpr size_t OFF_WQUP = OFF_WIN + 2816ull * 1024 * 2;
constexpr size_t OFF_WKVUP = OFF_WQUP + 768ull * 384 * 2;
constexpr size_t OFF_WOUT = OFF_WKVUP + 1024ull * 256 * 2;
constexpr size_t OFF_MODS = OFF_WOUT + 1024ull * 1024 * 2;
constexpr size_t OFF_RH = OFF_MODS + 2ull * 9 * 9216 * 4;
constexpr size_t OFF_SIDE = OFF_RH + 2048ull * 1024 * 4;
constexpr size_t OFF_REGA = OFF_SIDE + (size_t)T * 32 * 4;
constexpr size_t OFF_REGB = OFF_REGA + (size_t)T * 1024 * 2;
constexpr size_t OFF_QB = OFF_REGB + (size_t)T * 2816 * 2;
constexpr size_t OFF_KB = OFF_QB + (size_t)T * 768 * 2;
constexpr size_t OFF_ODIR = OFF_KB + (size_t)T * 768 * 2;
constexpr size_t OFF_BAR = OFF_ODIR + 2ull * T * 512 * 2;
constexpr size_t WS_NEED = OFF_BAR + 32768;

struct P {
  const float *x, *c, *ctx, *c_ctx, *ada_w, *ada_b, *norm_g, *ffn_g, *ffn_u, *ffn_d;
  const float *ev_w_in, *ev_q_a_norm, *ev_w_q_up, *ev_kv_a_norm, *ev_w_kv_up, *ev_q_norm, *ev_k_norm, *ev_conv,
      *ev_a_log, *ev_dt_bias, *ev_out_norm, *ev_w_out;
  const float *od_w_in, *od_w2, *od_gb, *od_out_norm, *od_q_norm, *od_k_norm, *od_sink, *od_w_out;
  float* out;
  char* ws;
};

DI int get_tid() {
  int t = threadIdx.x;
  asm volatile("" : "+v"(t));
  return t;
}
DI u16 f2bf(float x) {
  return __builtin_bit_cast(u16, (__bf16)x);
}
DI float bf2f(u16 v) { return __uint_as_float(((unsigned)v) << 16); }
typedef __bf16 bf16x2v __attribute__((ext_vector_type(2)));
DI unsigned pack2(float a, float b) {
  const f32x2 v = {a, b};
  return __builtin_bit_cast(unsigned, __builtin_convertvector(v, bf16x2v));
}
DI float bflo(unsigned w) { return __uint_as_float(w << 16); }
DI float bfhi(unsigned w) { return __uint_as_float(w & 0xffff0000u); }
DI void unpack8(uint4 v, float* f) {
  f[0] = bflo(v.x); f[1] = bfhi(v.x); f[2] = bflo(v.y); f[3] = bfhi(v.y);
  f[4] = bflo(v.z); f[5] = bfhi(v.z); f[6] = bflo(v.w); f[7] = bfhi(v.w);
}
DI void unpack8v(u32x4 v, float* f) {
  f[0] = bflo(v.x); f[1] = bfhi(v.x); f[2] = bflo(v.y); f[3] = bfhi(v.y);
  f[4] = bflo(v.z); f[5] = bfhi(v.z); f[6] = bflo(v.w); f[7] = bfhi(v.w);
}
DI uint4 pack8(const float* f) {
  uint4 v;
  v.x = pack2(f[0], f[1]); v.y = pack2(f[2], f[3]); v.z = pack2(f[4], f[5]); v.w = pack2(f[6], f[7]);
  return v;
}
DI float wave_sum(float v) {
  v += __shfl_xor(v, 32); v += __shfl_xor(v, 16); v += __shfl_xor(v, 8);
  v += __shfl_xor(v, 4); v += __shfl_xor(v, 2); v += __shfl_xor(v, 1);
  return v;
}
DI float quad_sum(float v) {
  v += __builtin_bit_cast(float, __builtin_amdgcn_mov_dpp(__builtin_bit_cast(int, v), 0xB1, 0xF, 0xF, true));
  v += __builtin_bit_cast(float, __builtin_amdgcn_mov_dpp(__builtin_bit_cast(int, v), 0x4E, 0xF, 0xF, true));
  return v;
}
DI float row16_sum(float v) {
  v += __builtin_bit_cast(float, __builtin_amdgcn_mov_dpp(__builtin_bit_cast(int, v), 0xB1, 0xF, 0xF, true));
  v += __builtin_bit_cast(float, __builtin_amdgcn_mov_dpp(__builtin_bit_cast(int, v), 0x4E, 0xF, 0xF, true));
  v += __builtin_bit_cast(float, __builtin_amdgcn_mov_dpp(__builtin_bit_cast(int, v), 0x141, 0xF, 0xF, true));
  v += __builtin_bit_cast(float, __builtin_amdgcn_mov_dpp(__builtin_bit_cast(int, v), 0x140, 0xF, 0xF, true));
  return v;
}
DI float row8_sum(float v) {
  v += __builtin_bit_cast(float, __builtin_amdgcn_mov_dpp(__builtin_bit_cast(int, v), 0xB1, 0xF, 0xF, true));
  v += __builtin_bit_cast(float, __builtin_amdgcn_mov_dpp(__builtin_bit_cast(int, v), 0x4E, 0xF, 0xF, true));
  v += __builtin_bit_cast(float, __builtin_amdgcn_mov_dpp(__builtin_bit_cast(int, v), 0x141, 0xF, 0xF, true));
  return v;
}
DI void wave_lds_sync() {
  asm volatile("s_waitcnt lgkmcnt(0)" ::: "memory");
  __builtin_amdgcn_wave_barrier();
}
DI float silu_f(float x) { return x * __builtin_amdgcn_rcpf(1.f + __expf(-x)); }
DI float sigmoid_f(float x) { return __builtin_amdgcn_rcpf(1.f + __expf(-x)); }
DI float softplus_f(float x) { return x > 20.f ? x : log1pf(__expf(x)); }

DI void conv_tile(const float* __restrict__ src, int N, u16* __restrict__ dst, int ldd, int k0, int n0, int mode,
                  const float* __restrict__ kscale, float* tl) {
  const int t = get_tid();
  const int r = t >> 4, c4 = (t & 15) * 4;
#pragma unroll
  for (int i = 0; i < 4; ++i) {
    const int k = r + 16 * i;
    float4 v = make_float4(0.f, 0.f, 0.f, 0.f);
    if (n0 + c4 < N) v = *(const float4*)(src + (size_t)(k0 + k) * N + n0 + c4);
    if (kscale) { const float s = kscale[k0 + k]; v.x *= s; v.y *= s; v.z *= s; v.w *= s; }
    float* q = tl + k * 65 + c4;
    q[0] = v.x; q[1] = v.y; q[2] = v.z; q[3] = v.w;
  }
  __syncthreads();
  const int n = t >> 2, ks = (t & 3) * 16;
  unsigned w[8];
#pragma unroll
  for (int j = 0; j < 8; ++j) w[j] = pack2(tl[(ks + 2 * j) * 65 + n], tl[(ks + 2 * j + 1) * 65 + n]);
  const int nn = n0 + n;
  const int drow = mode == 0 ? nn : ((nn >> 5) * 64 + (nn & 31) + (mode == 2 ? 32 : 0));
  uint4* d = (uint4*)(dst + (size_t)drow * ldd + k0 + ks);
  d[0] = make_uint4(w[0], w[1], w[2], w[3]);
  d[1] = make_uint4(w[4], w[5], w[6], w[7]);
  __syncthreads();
}

DI void convert_weights(const P& p, int layer, char* smem, int vb, int nvb, int part) {
  float* tl = (float*)smem;
  char* ws = p.ws;
  const int nFF = 704;
  const int nIn = (layer == 0 ? EVEN_PAD : ODD_PAD) / 64 * 16;
  const int nQ = layer == 0 ? 72 : 0, nKV = layer == 0 ? 64 : 0;
  const int nEarly = 3 * nFF + nIn + nQ + nKV, nLate = 3 * nFF + 256;
  const int total = part == 0 ? nEarly : nLate;
  for (int job = vb; job < total; job += nvb) {
    int j = part == 0 ? (job < 3 * nFF ? job : job + 3 * nFF)
                      : (job < 3 * nFF ? job + 3 * nFF : 6 * nFF + nIn + nQ + nKV + (job - 3 * nFF));
    if (j < 6 * nFF) {
      const int s = j / (3 * nFF);
      int jj = j % (3 * nFF);
      const int which = jj / nFF;
      jj %= nFF;
      const size_t woff = ((size_t)layer * 2 + s) * 1024 * 2816;
      if (which < 2) {
        const float* src = (which == 0 ? p.ffn_g : p.ffn_u) + woff;
        u16* dst = (u16*)(ws + OFF_WGU) + (size_t)s * 5632 * 1024;
        conv_tile(src, 2816, dst, 1024, (jj / 44) * 64, (jj % 44) * 64, 1 + which, nullptr, tl);
      } else {
        const float* src = p.ffn_d + woff;
        u16* dst = (u16*)(ws + OFF_WDN) + (size_t)s * 1024 * 2816;
        conv_tile(src, 1024, dst, 2816, (jj / 16) * 64, (jj % 16) * 64, 0, nullptr, tl);
      }
      continue;
    }
    j -= 6 * nFF;
    if (j < nIn) {
      const int N = layer == 0 ? EVEN_IN : ODD_IN;
      const int ntn = (layer == 0 ? EVEN_PAD : ODD_PAD) / 64;
      const float* src = layer == 0 ? p.ev_w_in : p.od_w_in;
      conv_tile(src, N, (u16*)(ws + OFF_WIN), 1024, (j / ntn) * 64, (j % ntn) * 64, 0, nullptr, tl);
      continue;
    }
    j -= nIn;
    if (j < nQ) {
      conv_tile(p.ev_w_q_up, 768, (u16*)(ws + OFF_WQUP), 384, (j / 12) * 64, (j % 12) * 64, 0, p.ev_q_a_norm, tl);
      continue;
    }
    j -= nQ;
    if (j < nKV) {
      conv_tile(p.ev_w_kv_up, 1024, (u16*)(ws + OFF_WKVUP), 256, (j / 16) * 64, (j % 16) * 64, 0, p.ev_kv_a_norm, tl);
      continue;
    }
    j -= nKV;
    {
      const float* src = layer == 0 ? p.ev_w_out : p.od_w_out;
      conv_tile(src, 1024, (u16*)(ws + OFF_WOUT), 1024, (j / 16) * 64, (j % 16) * 64, 0, nullptr, tl);
    }
  }
}

DI void mods_phase(const P& p, char* smem, int vb, int nvb) {
  float* sc = (float*)smem;
  float* red = sc + 9 * 1024;
  float* mods = (float*)(p.ws + OFF_MODS);
  const int t = get_tid();
  bool loaded = false;
  for (int job = vb; job < 576; job += nvb) {
    if (!loaded) {
      for (int i = t; i < 9 * 1024; i += NTHR) {
        const float v = i < 8192 ? p.c[i] : p.c_ctx[i - 8192];
        sc[i] = silu_f(v);
      }
      loaded = true;
      __syncthreads();
    }
    const int l = job / 288, n0 = (job % 288) * 32;
    const int c4 = (t & 7) * 4, ksl = t >> 3;
    float4 acc[9];
#pragma unroll
    for (int r = 0; r < 9; ++r) acc[r] = make_float4(0.f, 0.f, 0.f, 0.f);
    const float* w = p.ada_w + (size_t)l * 1024 * 9216 + n0 + c4;
#pragma unroll 8
    for (int kk = 0; kk < 32; ++kk) {
      const int k = ksl * 32 + kk;
      const float4 wv = *(const float4*)(w + (size_t)k * 9216);
#pragma unroll
      for (int r = 0; r < 9; ++r) {
        const float sv = sc[r * 1024 + k];
        acc[r].x += sv * wv.x; acc[r].y += sv * wv.y; acc[r].z += sv * wv.z; acc[r].w += sv * wv.w;
      }
    }
#pragma unroll
    for (int r = 0; r < 9; ++r) *(float4*)(red + (ksl * 9 + r) * 32 + c4) = acc[r];
    __syncthreads();
    for (int i = t; i < 9 * 32; i += NTHR) {
      const int r = i >> 5, cc = i & 31;
      float v = p.ada_b[(size_t)l * 9216 + n0 + cc];
#pragma unroll
      for (int sl = 0; sl < 32; ++sl) v += red[(sl * 9 + r) * 32 + cc];
      mods[((size_t)l * 9 + r) * 9216 + n0 + cc] = v;
    }
    __syncthreads();
  }
}

DI void normmod_phase(const P& p, int layer, int which, int nrows, bool first, int vb, int nvb) {
  const int tid_ = get_tid();
  const int lane = tid_ & 63, wave = tid_ >> 6;
  u16* dst = (u16*)(p.ws + OFF_REGA);
  float* rh = (float*)(p.ws + OFF_RH);
  const float* mods = (const float*)(p.ws + OFF_MODS) + (size_t)layer * 9 * 9216;
  const float* g = p.norm_g + ((size_t)layer * 3 + which) * 1024;
  const int shift_i = which * 3, scale_i = which * 3 + 1;
  const int nw = nvb * 4;
  const int per = (nrows + nw - 1) / nw;
  const int row0 = (vb * 4 + wave) * per;
  const int row1 = row0 + per < nrows ? row0 + per : nrows;
  f32x4v gg[4], sh[4], sc1[4];
#pragma unroll
  for (int i = 0; i < 4; ++i) {
    gg[i] = *(const f32x4v*)(g + i * 256 + lane * 4);
    sh[i] = (f32x4v){0.f, 0.f, 0.f, 0.f};
    sc1[i] = (f32x4v){1.f, 1.f, 1.f, 1.f};
  }
  int crg = -1;
  for (int row = row0; row < row1; ++row) {
    const float* src;
    float* res = row < LAT ? p.out + (size_t)row * 1024 : rh + (size_t)(row - LAT) * 1024;
    if (first) src = row < LAT ? p.x + (size_t)row * 1024 : p.ctx + (size_t)(row - LAT) * 1024;
    else src = res;
    const int rg = row < LAT ? (row >> 11) : 8;
    if (rg != crg) {
      const float* mrow = mods + (size_t)rg * 9216;
#pragma unroll
      for (int i = 0; i < 4; ++i) {
        sh[i] = *(const f32x4v*)(mrow + shift_i * 1024 + i * 256 + lane * 4);
        sc1[i] = *(const f32x4v*)(mrow + scale_i * 1024 + i * 256 + lane * 4) + 1.f;
        sc1[i] *= gg[i];
      }
      crg = rg;
    }
    f32x4v v[4];
    float ss = 0.f;
#pragma unroll
    for (int i = 0; i < 4; ++i) {
      v[i] = *(const f32x4v*)(src + i * 256 + lane * 4);
      ss += v[i].x * v[i].x + v[i].y * v[i].y + v[i].z * v[i].z + v[i].w * v[i].w;
    }
    ss = wave_sum(ss);
    const float rinv = rsqrtf(ss * (1.f / 1024.f) + EPS);
#pragma unroll
    for (int i = 0; i < 4; ++i) {
      const int col = i * 256 + lane * 4;
      if (first) *(f32x4v*)(res + col) = v[i];
      const f32x4v y = v[i] * rinv * sc1[i] + sh[i];
      uint2 o;
      o.x = pack2(y.x, y.y); o.y = pack2(y.z, y.w);
      *(uint2*)(dst + (size_t)row * 1024 + col) = o;
    }
  }
}

struct GemmDesc {
  const u16* A0; int lda0; int kstep0; int ksplit;
  const u16* A1; int lda1;
  const u16* Bt; int K; int nM; int nN;
  u16* o16; int ldo; int nreal; float* side; int slo;
  float* xres; float* hres; const float* mod; int gidx; float coef;
};
constexpr int EPI_SWIGLU = 0, EPI_RES = 1, EPI_STORE = 2;

template <int EPI, int MI>
DI void gemm_tile(const GemmDesc& g, int tm, int tn, char* smem) {
  constexpr int BM = 64 * MI, ABYTES = BM * 128;
  char* As = smem;
  char* Bs = smem + 2 * ABYTES;
  const int tid = get_tid(), lane = tid & 63, wave = tid >> 6, r = lane & 31, hh = lane >> 5;
  const int wm = wave >> 1, wn = wave & 1;
  const int m0 = tm * BM, n0 = tn * 128;
  const int nk = g.K >> 6;
  f32x16 acc[MI][2];
#pragma unroll
  for (int a = 0; a < MI; ++a)
#pragma unroll
    for (int b = 0; b < 2; ++b)
#pragma unroll
      for (int i = 0; i < 16; ++i) acc[a][b][i] = 0.f;
  const int srow = tid >> 3;
  const int schunk = (tid & 7) ^ ((srow & 7) ^ ((srow >> 3) & 3));
#define G_GLDS(KT, BUF)                                                                               \
  {                                                                                                   \
    const int kt_ = (KT);                                                                             \
    const u16* Ab_; int lda_;                                                                         \
    if (kt_ < g.ksplit) { Ab_ = g.A0 + kt_ * g.kstep0; lda_ = g.lda0; }                              \
    else { Ab_ = g.A1 + (kt_ - g.ksplit) * 64; lda_ = g.lda1; }                                       \
    const u16* pa_ = Ab_ + (size_t)(m0 + srow) * lda_ + schunk * 8;                                   \
    const u16* pb_ = g.Bt + (size_t)(n0 + srow) * g.K + kt_ * 64 + schunk * 8;                        \
    char* la_ = As + (BUF) * ABYTES + tid * 16;                                                       \
    char* lb_ = Bs + (BUF) * 16384 + tid * 16;                                                        \
    _Pragma("unroll") for (int i = 0; i < 2 * MI; ++i)                                                \
      __builtin_amdgcn_global_load_lds((const unsigned*)(pa_ + (size_t)(32 * i) * lda_),             \
                                       (LAS3 unsigned*)(la_ + i * 4096), 16, 0, 0);                   \
    _Pragma("unroll") for (int i = 0; i < 4; ++i)                                                     \
      __builtin_amdgcn_global_load_lds((const unsigned*)(pb_ + (size_t)(32 * i) * g.K),              \
                                       (LAS3 unsigned*)(lb_ + i * 4096), 16, 0, 0);                   \
  }
  const int rowA = wm * (32 * MI) + r, rowB = wn * 64 + r;
  const int hk = hh ^ ((r & 7) ^ ((r >> 3) & 3));
#define G_COMPUTE(BUF)                                                                                \
  {                                                                                                   \
    const char* Ab = As + (BUF) * ABYTES + rowA * 128;                                                \
    const char* Bb = Bs + (BUF) * 16384 + rowB * 128;                                                 \
    _Pragma("unroll") for (int ks = 0; ks < 4; ++ks) {                                                \
      const int oc = (hk ^ (ks * 2)) << 4;                                                            \
      const bf16x8 b0 = *(const bf16x8*)(Bb + oc);                                                    \
      const bf16x8 b1 = *(const bf16x8*)(Bb + 32 * 128 + oc);                                         \
      _Pragma("unroll") for (int mi = 0; mi < MI; ++mi) {                                             \
        const bf16x8 a0 = *(const bf16x8*)(Ab + mi * 32 * 128 + oc);                                  \
        acc[mi][0] = MFMA(a0, b0, acc[mi][0]);                                                        \
        acc[mi][1] = MFMA(a0, b1, acc[mi][1]);                                                        \
      }                                                                                               \
    }                                                                                                 \
  }
  G_GLDS(0, 0);
  asm volatile("s_waitcnt vmcnt(0)" ::: "memory");
  __syncthreads();
  for (int kt = 0; kt < nk; kt += 2) {
    if (kt + 1 < nk) G_GLDS(kt + 1, 1);
    G_COMPUTE(0);
    asm volatile("s_waitcnt vmcnt(0)" ::: "memory");
    __syncthreads();
    if (kt + 1 < nk) {
      if (kt + 2 < nk) G_GLDS(kt + 2, 0);
      G_COMPUTE(1);
      asm volatile("s_waitcnt vmcnt(0)" ::: "memory");
      __syncthreads();
    }
  }
#undef G_GLDS
#undef G_COMPUTE
  if (EPI == EPI_SWIGLU) {
    u16* es = (u16*)smem;
#pragma unroll
    for (int mi = 0; mi < MI; ++mi)
#pragma unroll
      for (int i = 0; i < 16; ++i) {
        const int lrow = wm * (32 * MI) + mi * 32 + (i & 3) + 8 * (i >> 2) + 4 * hh;
        es[lrow * 64 + wn * 32 + r] = f2bf(silu_f(acc[mi][0][i]) * acc[mi][1][i]);
      }
    __syncthreads();
#pragma unroll
    for (int j = 0; j < 2 * MI; ++j) {
      const int lrow = (tid >> 3) + 32 * j, ch = tid & 7;
      const u32x4 v = *(const u32x4*)(es + lrow * 64 + ch * 8);
      *(u32x4*)(g.o16 + (size_t)(m0 + lrow) * g.ldo + (n0 >> 1) + ch * 8) = v;
    }
    __syncthreads();
  } else if (EPI == EPI_RES) {
    float* es = (float*)smem;
    const int c4 = (tid & 31) * 4;
    const int rgA = m0 < LAT ? (m0 >> 11) : 8;
    const int mlast = m0 + BM - 1;
    const int rgB = mlast < LAT ? (mlast >> 11) : 8;
    const f32x4v m4a = *(const f32x4v*)(g.mod + (size_t)rgA * 9216 + g.gidx * 1024 + n0 + c4);
    const f32x4v m4b = *(const f32x4v*)(g.mod + (size_t)rgB * 9216 + g.gidx * 1024 + n0 + c4);
#pragma unroll
    for (int mi = 0; mi < MI; ++mi) {
#pragma unroll
      for (int ni = 0; ni < 2; ++ni)
#pragma unroll
        for (int i = 0; i < 16; ++i) {
          const int lrow = wm * 32 + (i & 3) + 8 * (i >> 2) + 4 * hh;
          es[lrow * 128 + wn * 64 + ni * 32 + r] = acc[mi][ni][i];
        }
      __syncthreads();
#pragma unroll 4
      for (int j = 0; j < 8; ++j) {
        const int lrow = (tid >> 5) + 8 * j;
        const int grow = m0 + (lrow >> 5) * (32 * MI) + mi * 32 + (lrow & 31);
        const f32x4v a4 = *(const f32x4v*)(es + lrow * 128 + c4);
        const int rg = grow < LAT ? (grow >> 11) : 8;
        const f32x4v m4 = rg == rgA ? m4a : m4b;
        float* rp = (grow < LAT ? g.xres + (size_t)grow * 1024 : g.hres + (size_t)(grow - LAT) * 1024) + n0 + c4;
        f32x4v x4 = *(const f32x4v*)rp;
        x4 += (m4 * a4) * g.coef;
        *(f32x4v*)rp = x4;
      }
      __syncthreads();
    }
  } else {
    u16* es = (u16*)smem;
#pragma unroll
    for (int mi = 0; mi < MI; ++mi)
#pragma unroll
      for (int ni = 0; ni < 2; ++ni)
#pragma unroll
        for (int i = 0; i < 16; ++i) {
          const int lrow = wm * (32 * MI) + mi * 32 + (i & 3) + 8 * (i >> 2) + 4 * hh;
          const int col = n0 + wn * 64 + ni * 32 + r;
          const float v = acc[mi][ni][i];
          es[lrow * 128 + wn * 64 + ni * 32 + r] = f2bf(v);
          if (g.side != nullptr && col >= g.slo && col < g.slo + 32) g.side[(size_t)(m0 + lrow) * 32 + col - g.slo] = v;
        }
    __syncthreads();
#pragma unroll
    for (int j = 0; j < 4 * MI; ++j) {
      const int lrow = (tid >> 4) + 16 * j, ch = tid & 15;
      const int col = n0 + ch * 8;
      if (col < g.nreal) *(u32x4*)(g.o16 + (size_t)(m0 + lrow) * g.ldo + col) = *(const u32x4*)(es + lrow * 128 + ch * 8);
    }
    __syncthreads();
  }
}

template <int EPI, int MI>
DI void gemm_phase(const GemmDesc& g, char* smem, int vb, int nvb) {
  const bool xm = (nvb & 7) == 0 && (g.nM & 7) == 0;
  const int xcd = vb & 7;
  const int mPer = xm ? (g.nM >> 3) : g.nM;
  const int PM = (mPer % 9 == 0) ? 9 : ((mPer & 7) == 0 ? 8 : ((mPer % 6) == 0 ? 6 : mPer));
  const int per = PM * g.nN;
  const int local = mPer * g.nN;
  const int start = xm ? (vb >> 3) : vb, step = xm ? (nvb >> 3) : nvb;
  const int mbase = xm ? xcd * mPer : 0;
  for (int q = start; q < local; q += step) {
    const int mg = q / per;
    const int rem = q - mg * per;
    const int tn = rem / PM;
    const int tm = mbase + mg * PM + (rem - tn * PM);
    gemm_tile<EPI, MI>(g, tm, tn, smem);
  }
}
template <int EPI>
DI void gemm_auto(GemmDesc& g, int M, char* smem, int vb, int nvb) {
  if (M == T) { g.nM = T / 192; gemm_phase<EPI, 3>(g, smem, vb, nvb); }
  else { g.nM = M / 128; gemm_phase<EPI, 2>(g, smem, vb, nvb); }
}

DI GemmDesc gemm_simple(const u16* A, int lda, const u16* Bt, int K, int M, int Npad) {
  GemmDesc g;
  g.A0 = A; g.lda0 = lda; g.kstep0 = 64; g.ksplit = 1 << 20; g.A1 = A; g.lda1 = lda;
  g.Bt = Bt; g.K = K; g.nM = M / 128; g.nN = Npad / 128;
  g.o16 = nullptr; g.ldo = 0; g.nreal = 0; g.side = nullptr; g.slo = 0;
  g.xres = nullptr; g.hres = nullptr; g.mod = nullptr; g.gidx = 0; g.coef = 0.f;
  return g;
}

DI void mla_finalize(const P& p, char* smem, int vb, int nvb) {
  const int tid_ = get_tid();
  const int lane = tid_ & 63, wave = tid_ >> 6;
  const u16* z = (const u16*)(p.ws + OFF_REGB);
  u16* Q = (u16*)(p.ws + OFF_QB);
  u16* Kb = (u16*)(p.ws + OFF_KB);
  u16* KV = (u16*)(p.ws + OFF_REGA);
  float* sq = (float*)smem + wave * 1824;
  float* skv = sq + 768;
  float* skr = skv + 1024;
  const int h = lane >> 3, sub = lane & 7;
  const float QSCALE = 0.10206207261596575f * LOG2E;
  float qn[12], kn[12];
#pragma unroll
  for (int j = 0; j < 12; ++j) { qn[j] = p.ev_q_norm[sub + 8 * j]; kn[j] = p.ev_k_norm[sub + 8 * j]; }
  for (int t = vb * 4 + wave; t < T; t += nvb * 4) {
    float f[8];
    {
      uint4 v = *(const uint4*)(Q + (size_t)t * 768 + lane * 8);
      unpack8(v, f);
#pragma unroll
      for (int j = 0; j < 8; ++j) sq[lane * 8 + j] = f[j];
      if (lane < 32) {
        v = *(const uint4*)(Q + (size_t)t * 768 + (lane + 64) * 8);
        unpack8(v, f);
#pragma unroll
        for (int j = 0; j < 8; ++j) sq[(lane + 64) * 8 + j] = f[j];
      }
    }
    uint4 kv0 = *(const uint4*)(KV + (size_t)t * 1024 + lane * 8);
    uint4 kv1 = *(const uint4*)(KV + (size_t)t * 1024 + (lane + 64) * 8);
    unpack8(kv0, f);
#pragma unroll
    for (int j = 0; j < 8; ++j) skv[lane * 8 + j] = f[j];
    unpack8(kv1, f);
#pragma unroll
    for (int j = 0; j < 8; ++j) skv[(lane + 64) * 8 + j] = f[j];
    if (lane < 32) skr[lane] = bf2f(z[(size_t)t * EVEN_IN + 640 + lane]);
    float ssq = 0.f, sskv = 0.f;
    if (lane < 48) {
      uint4 v = *(const uint4*)(z + (size_t)t * EVEN_IN + lane * 8);
      unpack8(v, f);
#pragma unroll
      for (int j = 0; j < 8; ++j) ssq += f[j] * f[j];
    }
    if (lane < 32) {
      uint4 v = *(const uint4*)(z + (size_t)t * EVEN_IN + 384 + lane * 8);
      unpack8(v, f);
#pragma unroll
      for (int j = 0; j < 8; ++j) sskv += f[j] * f[j];
    }
    ssq = wave_sum(ssq);
    sskv = wave_sum(sskv);
    const float rq = rsqrtf(ssq * (1.f / 384.f) + EPS), rkv = rsqrtf(sskv * (1.f / 256.f) + EPS);
    const bool lat = t < LAT;
    const int pos = t & 2047;
    float cs = 1.f, sn = 0.f;
    if (lat) {
      const int fi = lane & 7;
      const float inv = exp2f(-(float)fi * (13.287712379549449f / 8.f));
      const float pc = (lane & 8) ? (float)(pos & 63) : (float)(pos >> 6);
      float rev = pc * inv * 0.15915494309189535f;
      rev -= floorf(rev);
      cs = __builtin_amdgcn_cosf(rev);
      sn = __builtin_amdgcn_sinf(rev);
    }
    const float c0 = __shfl(cs, sub), s0 = __shfl(sn, sub), c1 = __shfl(cs, sub + 8), s1 = __shfl(sn, sub + 8);
    wave_lds_sync();
    float y[12];
    float ss = 0.f;
#pragma unroll
    for (int j = 0; j < 12; ++j) { y[j] = sq[h * 96 + sub + 8 * j] * rq; ss += y[j] * y[j]; }
    ss += __shfl_xor(ss, 1); ss += __shfl_xor(ss, 2); ss += __shfl_xor(ss, 4);
    float rms = rsqrtf(ss * (1.f / 96.f) + EPS);
#pragma unroll
    for (int j = 0; j < 12; ++j) y[j] *= rms * qn[j];
    if (lat) {
      const float a8 = y[8] * c0 - y[10] * s0, a10 = y[8] * s0 + y[10] * c0;
      const float a9 = y[9] * c1 - y[11] * s1, a11 = y[9] * s1 + y[11] * c1;
      y[8] = a8; y[10] = a10; y[9] = a9; y[11] = a11;
    }
    float kk[12];
    float ssk = 0.f;
#pragma unroll
    for (int j = 0; j < 12; ++j) {
      kk[j] = j < 8 ? skv[h * 128 + sub + 8 * j] * rkv : skr[sub + 8 * j - 64];
      ssk += kk[j] * kk[j];
    }
    ssk += __shfl_xor(ssk, 1); ssk += __shfl_xor(ssk, 2); ssk += __shfl_xor(ssk, 4);
    rms = rsqrtf(ssk * (1.f / 96.f) + EPS);
#pragma unroll
    for (int j = 0; j < 12; ++j) kk[j] *= rms * kn[j];
    if (lat) {
      const float a8 = kk[8] * c0 - kk[10] * s0, a10 = kk[8] * s0 + kk[10] * c0;
      const float a9 = kk[9] * c1 - kk[11] * s1, a11 = kk[9] * s1 + kk[11] * c1;
      kk[8] = a8; kk[10] = a10; kk[9] = a9; kk[11] = a11;
    }
    wave_lds_sync();
#pragma unroll
    for (int j = 0; j < 12; ++j) sq[h * 96 + sub + 8 * j] = y[j] * QSCALE;
    wave_lds_sync();
    {
      *(uint4*)(Q + (size_t)t * 768 + lane * 8) = pack8(sq + lane * 8);
      if (lane < 32) *(uint4*)(Q + (size_t)t * 768 + (lane + 64) * 8) = pack8(sq + (lane + 64) * 8);
    }
    wave_lds_sync();
#pragma unroll
    for (int j = 0; j < 12; ++j) sq[h * 96 + sub + 8 * j] = kk[j];
    wave_lds_sync();
    {
      *(uint4*)(Kb + (size_t)t * 768 + lane * 8) = pack8(sq + lane * 8);
      if (lane < 32) *(uint4*)(Kb + (size_t)t * 768 + (lane + 64) * 8) = pack8(sq + (lane + 64) * 8);
    }
    if (lane & 8) {
      unpack8(kv0, f);
#pragma unroll
      for (int j = 0; j < 8; ++j) f[j] *= rkv;
      *(uint4*)(KV + (size_t)t * 1024 + lane * 8) = pack8(f);
      unpack8(kv1, f);
#pragma unroll
      for (int j = 0; j < 8; ++j) f[j] *= rkv;
      *(uint4*)(KV + (size_t)t * 1024 + (lane + 64) * 8) = pack8(f);
    }
    wave_lds_sync();
  }
}

DI void swa_finalize(const P& p, char* smem, int vb, int nvb) {
  const int tid_ = get_tid();
  const int lane = tid_ & 63, wave = tid_ >> 6;
  const u16* z = (const u16*)(p.ws + OFF_REGB);
  u16* Q = (u16*)(p.ws + OFF_QB);
  u16* Kb = (u16*)(p.ws + OFF_KB);
  const int sub = lane & 7;
  const float SSCALE = 0.125f * LOG2E;
  float qn[8], kn[8];
#pragma unroll
  for (int j = 0; j < 8; ++j) { qn[j] = p.od_q_norm[sub * 8 + j]; kn[j] = p.od_k_norm[sub * 8 + j]; }
  const float* side = (const float*)(p.ws + OFF_SIDE);
  float* alpha0 = (float*)(p.ws + OFF_KB + (size_t)T * 128 * 2);
  float* alpha1 = (float*)(p.ws + OFF_REGA + (size_t)LAT * 512 * 2);
  float* w2s = (float*)smem;
  float* gbs = w2s + 8192;
  float* sds = gbs + 512 + wave * 32;
  __syncthreads();
  for (int i = tid_; i < 8192; i += NTHR) w2s[i] = p.od_w2[i];
  for (int i = tid_; i < 512; i += NTHR) gbs[i] = p.od_gb[i];
  __syncthreads();
  for (int t = vb * 4 + wave; t < T; t += nvb * 4) {
    if (lane < 32) sds[lane] = side[(size_t)t * 32 + lane];
    wave_lds_sync();
#pragma unroll
    for (int dr = 0; dr < 2; ++dr) {
      f32x4v lg = *(const f32x4v*)(gbs + dr * 256 + lane * 4);
#pragma unroll
      for (int r4 = 0; r4 < 4; ++r4) {
        const f32x4v zg = *(const f32x4v*)(sds + dr * 16 + r4 * 4);
        lg += *(const f32x4v*)(w2s + (dr * 16 + r4 * 4 + 0) * 256 + lane * 4) * zg.x;
        lg += *(const f32x4v*)(w2s + (dr * 16 + r4 * 4 + 1) * 256 + lane * 4) * zg.y;
        lg += *(const f32x4v*)(w2s + (dr * 16 + r4 * 4 + 2) * 256 + lane * 4) * zg.z;
        lg += *(const f32x4v*)(w2s + (dr * 16 + r4 * 4 + 3) * 256 + lane * 4) * zg.w;
      }
      f32x4v al;
      al.x = __expf((fminf(lg.x, 0.f) - __logf(1.f + __expf(-fabsf(lg.x)))) * (1.f / 16.f));
      al.y = __expf((fminf(lg.y, 0.f) - __logf(1.f + __expf(-fabsf(lg.y)))) * (1.f / 16.f));
      al.z = __expf((fminf(lg.z, 0.f) - __logf(1.f + __expf(-fabsf(lg.z)))) * (1.f / 16.f));
      al.w = __expf((fminf(lg.w, 0.f) - __logf(1.f + __expf(-fabsf(lg.w)))) * (1.f / 16.f));
      *(f32x4v*)((dr == 0 ? alpha0 : alpha1) + (size_t)t * 256 + lane * 4) = al;
    }
    wave_lds_sync();
    const bool lat = t < LAT;
    const int pos = t & 2047;
    float cs = 1.f, sn = 0.f;
    if (lat) {
      const int fi = lane & 15;
      const float inv = exp2f(-(float)fi * (13.287712379549449f / 16.f));
      const float pc = (lane & 16) ? (float)(pos & 63) : (float)(pos >> 6);
      float rev = pc * inv * 0.15915494309189535f;
      rev -= floorf(rev);
      cs = __builtin_amdgcn_cosf(rev);
      sn = __builtin_amdgcn_sinf(rev);
    }
    float cj[8], sj[8];
#pragma unroll
    for (int j = 0; j < 8; ++j) { cj[j] = __shfl(cs, (sub & 3) * 8 + j); sj[j] = __shfl(sn, (sub & 3) * 8 + j); }
    float f[8];
    if (lat) {
      uint4 v = *(const uint4*)(z + (size_t)t * ODD_IN + 1568 + lane * 8);
      unpack8(v, f);
      float ss = 0.f;
#pragma unroll
      for (int j = 0; j < 8; ++j) ss += f[j] * f[j];
      ss += __shfl_xor(ss, 1); ss += __shfl_xor(ss, 2); ss += __shfl_xor(ss, 4);
      const float rms = rsqrtf(ss * (1.f / 64.f) + EPS);
#pragma unroll
      for (int j = 0; j < 8; ++j) {
        const float yv = f[j] * rms * qn[j];
        const float pv = __shfl_xor(yv, 4);
        const float o = (sub < 4) ? (yv * cj[j] - pv * sj[j]) : (pv * sj[j] + yv * cj[j]);
        f[j] = o * SSCALE;
      }
      *(uint4*)(Q + (size_t)t * 512 + lane * 8) = pack8(f);
    }
    {
      const int l16 = lane & 15;
      uint4 v = *(const uint4*)(z + (size_t)t * ODD_IN + 2080 + l16 * 8);
      unpack8(v, f);
      float ss = 0.f;
#pragma unroll
      for (int j = 0; j < 8; ++j) ss += f[j] * f[j];
      ss += __shfl_xor(ss, 1); ss += __shfl_xor(ss, 2); ss += __shfl_xor(ss, 4);
      const float rms = rsqrtf(ss * (1.f / 64.f) + EPS);
#pragma unroll
      for (int j = 0; j < 8; ++j) {
        const float yv = f[j] * rms * kn[j];
        const float pv = __shfl_xor(yv, 4);
        float o = yv;
        if (lat) o = (sub < 4) ? (yv * cj[j] - pv * sj[j]) : (pv * sj[j] + yv * cj[j]);
        f[j] = o;
      }
      if (lane < 16) *(uint4*)(Kb + (size_t)t * 128 + lane * 8) = pack8(f);
    }
  }
}

template <int DQK, bool SWA>
DI void attn_item(const u16* __restrict__ Q, int ldq, int qoff, const u16* __restrict__ Kp, int ldk, int koff,
                  const u16* __restrict__ Vp, int ldv, int voff, int qrow0, int qpos0, int crow0, int lrow0, int kt_lo,
                  int kt_hi, float sink2, u16* __restrict__ O, int ldo, int ooff, char* smem) {
  constexpr int KSTR = DQK + 8, VSTR = 72, CPR = DQK / 8, NKC = 64 * CPR / 256, NKS = DQK / 16;
  u16* Ks = (u16*)smem;
  u16* Vt = Ks + 2 * 64 * KSTR;
  const int tid = get_tid(), lane = tid & 63, wave = tid >> 6, r = lane & 31, hh = lane >> 5;
  const int nt = 4 + (kt_hi - kt_lo);
  bf16x8 bq[NKS];
  {
    const u16* qp = Q + (size_t)(qrow0 + wave * 32 + r) * ldq + qoff + hh * 8;
#pragma unroll
    for (int ks = 0; ks < NKS; ++ks) bq[ks] = *(const bf16x8*)(qp + ks * 16);
  }
  u32x4 rk[NKC], rv[2];
#define A_LOADG(IT)                                                                                   \
  {                                                                                                   \
    const int i_ = (IT);                                                                              \
    const int base_ = i_ < 4 ? crow0 + i_ * 64 : lrow0 + (kt_lo + i_ - 4) * 64;                       \
    _Pragma("unroll") for (int j = 0; j < NKC; ++j) {                                                 \
      const int c = tid + 256 * j, row = c / CPR, kc = c % CPR;                                       \
      rk[j] = *(const u32x4*)(Kp + (size_t)(base_ + row) * ldk + koff + kc * 8);                      \
    }                                                                                                 \
    _Pragma("unroll") for (int j = 0; j < 2; ++j) {                                                   \
      const int c = tid + 256 * j, row = c >> 3, dc = c & 7;                                          \
      rv[j] = *(const u32x4*)(Vp + (size_t)(base_ + row) * ldv + voff + dc * 8);                      \
    }                                                                                                 \
  }
#define A_STORES(BUF)                                                                                 \
  {                                                                                                   \
    const int buf_ = (BUF);                                                                           \
    _Pragma("unroll") for (int j = 0; j < NKC; ++j) {                                                 \
      const int c = tid + 256 * j, row = c / CPR, kc = c % CPR;                                       \
      *(u32x4*)(Ks + buf_ * 64 * KSTR + row * KSTR + kc * 8) = rk[j];                                 \
    }                                                                                                 \
    _Pragma("unroll") for (int j = 0; j < 2; ++j) {                                                   \
      const int c = tid + 256 * j, key = c >> 3, dc = c & 7;                                          \
      u16* vb = Vt + buf_ * 64 * VSTR + (dc * 8) * VSTR + key;                                        \
      const unsigned w0 = rv[j].x, w1 = rv[j].y, w2 = rv[j].z, w3 = rv[j].w;                          \
      vb[0 * VSTR] = (u16)(w0 & 0xffff); vb[1 * VSTR] = (u16)(w0 >> 16);                              \
      vb[2 * VSTR] = (u16)(w1 & 0xffff); vb[3 * VSTR] = (u16)(w1 >> 16);                              \
      vb[4 * VSTR] = (u16)(w2 & 0xffff); vb[5 * VSTR] = (u16)(w2 >> 16);                              \
      vb[6 * VSTR] = (u16)(w3 & 0xffff); vb[7 * VSTR] = (u16)(w3 >> 16);                              \
    }                                                                                                 \
  }
  f32x16 o[2];
#pragma unroll
  for (int a = 0; a < 2; ++a)
#pragma unroll
    for (int i = 0; i < 16; ++i) o[a][i] = 0.f;
  float m = -INFINITY, lsum = 0.f;
  A_LOADG(0);
  A_STORES(0);
  __syncthreads();
  for (int it = 0; it < nt; ++it) {
    const int buf = it & 1;
    if (it + 1 < nt) A_LOADG(it + 1);
    f32x16 s[2];
#pragma unroll
    for (int mt = 0; mt < 2; ++mt) {
#pragma unroll
      for (int i = 0; i < 16; ++i) s[mt][i] = 0.f;
      const u16* kb = Ks + buf * 64 * KSTR + (mt * 32 + r) * KSTR + hh * 8;
#pragma unroll
      for (int ks = 0; ks < NKS; ++ks) {
        const bf16x8 a = *(const bf16x8*)(kb + ks * 16);
        s[mt] = MFMA(a, bq[ks], s[mt]);
      }
    }
    if (SWA && it >= 4) {
      const int kpos0 = (kt_lo + it - 4) * 64;
      const int qpos = qpos0 + wave * 32 + r;
#pragma unroll
      for (int mt = 0; mt < 2; ++mt)
#pragma unroll
        for (int i = 0; i < 16; ++i) {
          const int kpos = kpos0 + mt * 32 + (i & 3) + 8 * (i >> 2) + 4 * hh;
          const int dlt = kpos - qpos;
          if (dlt > 128 || dlt < -128) s[mt][i] = -INFINITY;
        }
    }
    float mx = -INFINITY;
#pragma unroll
    for (int mt = 0; mt < 2; ++mt)
#pragma unroll
      for (int i = 0; i < 16; ++i) mx = fmaxf(mx, s[mt][i]);
    mx = fmaxf(mx, __shfl_xor(mx, 32));
    const float mnew = fmaxf(m, mx);
    const float alpha = __builtin_amdgcn_exp2f(m - mnew);
    m = mnew;
    float psum = 0.f;
#pragma unroll
    for (int mt = 0; mt < 2; ++mt)
#pragma unroll
      for (int i = 0; i < 16; ++i) {
        const float pv = __builtin_amdgcn_exp2f(s[mt][i] - mnew);
        s[mt][i] = pv;
        psum += pv;
      }
    lsum = lsum * alpha + psum;
#pragma unroll
    for (int a = 0; a < 2; ++a)
#pragma unroll
      for (int i = 0; i < 16; ++i) o[a][i] *= alpha;
#pragma unroll
    for (int mt = 0; mt < 2; ++mt)
#pragma unroll
      for (int sx = 0; sx < 2; ++sx) {
        uint4 pu;
        pu.x = pack2(s[mt][8 * sx + 0], s[mt][8 * sx + 1]);
        pu.y = pack2(s[mt][8 * sx + 2], s[mt][8 * sx + 3]);
        pu.z = pack2(s[mt][8 * sx + 4], s[mt][8 * sx + 5]);
        pu.w = pack2(s[mt][8 * sx + 6], s[mt][8 * sx + 7]);
        const bf16x8 pfv = __builtin_bit_cast(bf16x8, pu);
#pragma unroll
        for (int dt = 0; dt < 2; ++dt) {
          const u16* vp = Vt + buf * 64 * VSTR + (dt * 32 + r) * VSTR + mt * 32 + 16 * sx + 4 * hh;
          const uint2 v0 = *(const uint2*)(vp);
          const uint2 v1 = *(const uint2*)(vp + 8);
          const uint4 vu = make_uint4(v0.x, v0.y, v1.x, v1.y);
          o[dt] = MFMA(__builtin_bit_cast(bf16x8, vu), pfv, o[dt]);
        }
      }
    if (it + 1 < nt) A_STORES(buf ^ 1);
    __syncthreads();
  }
  float l = lsum + __shfl_xor(lsum, 32);
  if (SWA) l += __builtin_amdgcn_exp2f(sink2 - m);
  const float inv = 1.f / l;
  u16* op = O + (size_t)(qrow0 + wave * 32 + r) * ldo + ooff;
#pragma unroll
  for (int dt = 0; dt < 2; ++dt)
#pragma unroll
    for (int g4 = 0; g4 < 4; ++g4) {
      uint2 w;
      w.x = pack2(o[dt][4 * g4 + 0] * inv, o[dt][4 * g4 + 1] * inv);
      w.y = pack2(o[dt][4 * g4 + 2] * inv, o[dt][4 * g4 + 3] * inv);
      *(uint2*)(op + dt * 32 + 8 * g4 + 4 * hh) = w;
    }
}

DI void gdn_chain(const P& p, int cid, char* smem) {
  const int eb = cid & 1, chn = cid >> 1;
  const int dir = chn >> 6, b = (chn >> 3) & 7, h = chn & 7;
  float* qs = (float*)smem;
  float* ks = qs + 4096;
  float* vs = ks + 4096;
  float* ob = vs + 2048;
  float* ps = ob + 2048;
  float* cw = ps + 256;
  u16* Qb = (u16*)(cw + 800);
  u16* Kb16 = Qb + 64 * 72;
  u16* CT = Kb16 + 64 * 72;
  u16* ST0 = CT + 32 * 72;
  float* gcs = (float*)(ST0 + 32 * 72);
  const int tid = get_tid(), lane = tid & 63, wave = tid >> 6;
  const u16* z = (const u16*)(p.ws + OFF_REGB);
  const float* side = (const float*)(p.ws + OFF_SIDE);
  u16* od = (u16*)(p.ws + OFF_ODIR) + (size_t)dir * T * 512;
  __syncthreads();
  for (int i = tid; i < 800; i += NTHR) {
    const int j = i / 160, cc = i % 160;
    const int chi = cc < 64 ? h * 64 + cc : (cc < 128 ? 512 + h * 64 + (cc - 64) : 1024 + h * 64 + eb * 32 + (cc - 128));
    cw[i] = p.ev_conv[j * 1536 + chi];
  }
  const float Aexp = __expf(p.ev_a_log[dir * 8 + h]);
  const float dtb = p.ev_dt_bias[dir * 8 + h];
  __builtin_amdgcn_s_setprio(3);
  f32x2 S[4];
#pragma unroll
  for (int i = 0; i < 4; ++i) S[i] = (f32x2){0.f, 0.f};
  const int dl = lane & 7, ec = wave * 8 + (lane >> 3);
  const int pp = tid >> 2, qd = tid & 3;
  __syncthreads();
  for (int seg = 0; seg < 2; ++seg) {
    const int len = seg == 0 ? CTXL : SEQ;
    const int base = seg == 0 ? LAT + b * CTXL : b * SEQ;
    for (int c = 0; c < len / 64; ++c) {
      {
        const int pos = c * 64 + pp;
        const int tau = dir ? len - 1 - pos : pos;
        float aq[16], ak[16], av[8];
#pragma unroll
        for (int i = 0; i < 16; ++i) { aq[i] = 0.f; ak[i] = 0.f; }
#pragma unroll
        for (int i = 0; i < 8; ++i) av[i] = 0.f;
#pragma unroll
        for (int j = 0; j < 5; ++j) {
          const int tt = tau + j - 2;
          if (tt >= 0 && tt < len) {
            const u16* zr = z + (size_t)(base + tt) * EVEN_IN + h * 64;
            float f[16];
            unpack8(*(const uint4*)(zr + 672 + qd * 16), f); unpack8(*(const uint4*)(zr + 672 + qd * 16 + 8), f + 8);
#pragma unroll
            for (int i = 0; i < 16; ++i) aq[i] += cw[j * 160 + qd * 16 + i] * f[i];
            unpack8(*(const uint4*)(zr + 1184 + qd * 16), f); unpack8(*(const uint4*)(zr + 1184 + qd * 16 + 8), f + 8);
#pragma unroll
            for (int i = 0; i < 16; ++i) ak[i] += cw[j * 160 + 64 + qd * 16 + i] * f[i];
            unpack8(*(const uint4*)(zr + 1696 + eb * 32 + qd * 8), f);
#pragma unroll
            for (int i = 0; i < 8; ++i) av[i] += cw[j * 160 + 128 + qd * 8 + i] * f[i];
          }
        }
        float sq2 = 0.f, sk2 = 0.f;
#pragma unroll
        for (int i = 0; i < 16; ++i) {
          aq[i] = silu_f(aq[i]); ak[i] = silu_f(ak[i]);
          sq2 += aq[i] * aq[i]; sk2 += ak[i] * ak[i];
        }
        sq2 = quad_sum(sq2);
        sk2 = quad_sum(sk2);
        const float rq = rsqrtf(sq2 + EPS) * 0.125f, rk = rsqrtf(sk2 + EPS);
#pragma unroll
        for (int i = 0; i < 16; ++i) { aq[i] *= rq; ak[i] *= rk; }
#pragma unroll
        for (int i = 0; i < 4; ++i) {
          *(float4*)(qs + pp * 64 + qd * 16 + i * 4) = make_float4(aq[4 * i], aq[4 * i + 1], aq[4 * i + 2], aq[4 * i + 3]);
          *(float4*)(ks + pp * 64 + qd * 16 + i * 4) = make_float4(ak[4 * i], ak[4 * i + 1], ak[4 * i + 2], ak[4 * i + 3]);
        }
        {
          u32x4 wq0, wq1, wk0, wk1;
          wq0.x = pack2(aq[0], aq[1]); wq0.y = pack2(aq[2], aq[3]); wq0.z = pack2(aq[4], aq[5]); wq0.w = pack2(aq[6], aq[7]);
          wq1.x = pack2(aq[8], aq[9]); wq1.y = pack2(aq[10], aq[11]); wq1.z = pack2(aq[12], aq[13]); wq1.w = pack2(aq[14], aq[15]);
          wk0.x = pack2(ak[0], ak[1]); wk0.y = pack2(ak[2], ak[3]); wk0.z = pack2(ak[4], ak[5]); wk0.w = pack2(ak[6], ak[7]);
          wk1.x = pack2(ak[8], ak[9]); wk1.y = pack2(ak[10], ak[11]); wk1.z = pack2(ak[12], ak[13]); wk1.w = pack2(ak[14], ak[15]);
          *(u32x4*)(Qb + pp * 72 + qd * 16) = wq0; *(u32x4*)(Qb + pp * 72 + qd * 16 + 8) = wq1;
          *(u32x4*)(Kb16 + pp * 72 + qd * 16) = wk0; *(u32x4*)(Kb16 + pp * 72 + qd * 16 + 8) = wk1;
        }
        *(float4*)(vs + pp * 32 + qd * 8) = make_float4(silu_f(av[0]), silu_f(av[1]), silu_f(av[2]), silu_f(av[3]));
        *(float4*)(vs + pp * 32 + qd * 8 + 4) = make_float4(silu_f(av[4]), silu_f(av[5]), silu_f(av[6]), silu_f(av[7]));
        float gsame = 0.f, kk = 0.f, g21 = 0.f;
#pragma unroll
        for (int i = 0; i < 16; ++i) {
          const float kp = __builtin_bit_cast(float, __builtin_amdgcn_mov_dpp(__builtin_bit_cast(int, ak[i]), 0x114, 0xF, 0xF, true));
          gsame += aq[i] * ak[i];
          kk += kp * ak[i];
          g21 += aq[i] * kp;
        }
        gsame = quad_sum(gsame);
        kk = quad_sum(kk);
        g21 = quad_sum(g21);
        if (qd == 0) {
          const float za = side[(size_t)(base + tau) * 32 + dir * 8 + h];
          const float zb = side[(size_t)(base + tau) * 32 + 16 + dir * 8 + h];
          const float gl_ = -Aexp * softplus_f(za + dtb);
          gcs[pp] = gl_;
          const float av_ = __expf(gl_);
          const float bv_ = sigmoid_f(zb);
          float* pr = ps + (pp >> 1) * 8;
          if (pp & 1) { pr[2] = av_; pr[3] = bv_; pr[4] = kk; pr[6] = g21; pr[7] = gsame; }
          else { pr[0] = av_; pr[1] = bv_; pr[5] = gsame; }
        }
      }
      __syncthreads();
      {
        u32x4 ws_;
        ws_.x = pack2(S[0].x, S[0].y); ws_.y = pack2(S[1].x, S[1].y); ws_.z = pack2(S[2].x, S[2].y); ws_.w = pack2(S[3].x, S[3].y);
        *(u32x4*)(ST0 + ec * 72 + dl * 8) = ws_;
        if (wave == 0) {
          float gv = gcs[lane];
#pragma unroll
          for (int off = 1; off < 64; off <<= 1) {
            const float tv = __shfl_up(gv, off);
            if (lane >= off) gv += tv;
          }
          gcs[lane] = gv;
        }
      }
#define GDN_LOAD2(M, X)                                                                     \
  X##k1a = *(const f32x4v*)(ks + (2 * (M)) * 64 + dl * 8); X##k1b = *(const f32x4v*)(ks + (2 * (M)) * 64 + dl * 8 + 4);         \
  X##k2a = *(const f32x4v*)(ks + (2 * (M) + 1) * 64 + dl * 8); X##k2b = *(const f32x4v*)(ks + (2 * (M) + 1) * 64 + dl * 8 + 4); \
  X##v1 = vs[(2 * (M)) * 32 + ec]; X##v2 = vs[(2 * (M) + 1) * 32 + ec];                      \
  X##s0 = *(const f32x4v*)(ps + (M) * 8); X##s1 = *(const f32x4v*)(ps + (M) * 8 + 4);        \
  __builtin_amdgcn_sched_barrier(0);
#define GDN_DOT(VA, VB, OUT)                                                                \
  {                                                                                         \
    f32x2 d_ = VA.xy * S[0] + VA.zw * S[1];                                                 \
    d_ += VB.xy * S[2] + VB.zw * S[3];                                                      \
    OUT = d_.x + d_.y;                                                                      \
  }
#define GDN_STEP2(MM, X)                                                                    \
  {                                                                                         \
    const float a1 = X##s0.x, b1 = X##s0.y, a2 = X##s0.z, b2 = X##s0.w;                     \
    const float kk = X##s1.x;                                                               \
    float p1, p2;                                                                           \
    GDN_DOT(X##k1a, X##k1b, p1) GDN_DOT(X##k2a, X##k2b, p2)                                 \
    p1 = row8_sum(p1); p2 = row8_sum(p2);                                                   \
    const float c1 = b1 * (X##v1 - a1 * p1);                                                \
    const float c2 = b2 * (X##v2 - a2 * (a1 * p2 + kk * c1));                               \
    const float a21 = a2 * a1, w1 = a2 * c1;                                                \
    const f32x2 A2 = (f32x2){a21, a21}, W1 = (f32x2){w1, w1}, C2 = (f32x2){c2, c2};          \
    S[0] = A2 * S[0] + X##k1a.xy * W1 + X##k2a.xy * C2;                                     \
    S[1] = A2 * S[1] + X##k1a.zw * W1 + X##k2a.zw * C2;                                     \
    S[2] = A2 * S[2] + X##k1b.xy * W1 + X##k2b.xy * C2;                                     \
    S[3] = A2 * S[3] + X##k1b.zw * W1 + X##k2b.zw * C2;                                     \
    if (dl == 0) *(unsigned*)(CT + ec * 72 + 2 * (MM)) = pack2(c1, c2);                     \
    __builtin_amdgcn_sched_barrier(0);                                                      \
  }
      f32x4v Ak1a, Ak1b, Ak2a, Ak2b, As0, As1;
      f32x4v Bk1a, Bk1b, Bk2a, Bk2b, Bs0, Bs1;
      float Av1, Av2, Bv1, Bv2;
      GDN_LOAD2(0, A)
      for (int m0 = 0; m0 < 32; m0 += 4) {
        GDN_LOAD2(m0 + 1, B) GDN_STEP2(m0, A)
        GDN_LOAD2(m0 + 2, A) GDN_STEP2(m0 + 1, B)
        GDN_LOAD2(m0 + 3, B) GDN_STEP2(m0 + 2, A)
        GDN_LOAD2(m0 + 4, A) GDN_STEP2(m0 + 3, B)
      }
      __syncthreads();
      if (wave < 2) {
        const int r = lane & 31, hh = lane >> 5, it = wave;
        const float gci = gcs[it * 32 + r];
        const float egi = __expf(gci);
        bf16x8 bqr[4], bqd[4];
#pragma unroll
        for (int ks = 0; ks < 4; ++ks) {
          const u32x4 raw = *(const u32x4*)(Qb + (it * 32 + r) * 72 + ks * 16 + hh * 8);
          bqr[ks] = __builtin_bit_cast(bf16x8, raw);
          u32x4 sc;
          sc.x = pack2(bflo(raw.x) * egi, bfhi(raw.x) * egi); sc.y = pack2(bflo(raw.y) * egi, bfhi(raw.y) * egi);
          sc.z = pack2(bflo(raw.z) * egi, bfhi(raw.z) * egi); sc.w = pack2(bflo(raw.w) * egi, bfhi(raw.w) * egi);
          bqd[ks] = __builtin_bit_cast(bf16x8, sc);
        }
        f32x16 o;
#pragma unroll
        for (int i = 0; i < 16; ++i) o[i] = 0.f;
#pragma unroll
        for (int ks = 0; ks < 4; ++ks) {
          const bf16x8 a = *(const bf16x8*)(ST0 + r * 72 + ks * 16 + hh * 8);
          o = MFMA(a, bqd[ks], o);
        }
        for (int jt = 0; jt <= it; ++jt) {
          f32x16 sT;
#pragma unroll
          for (int i = 0; i < 16; ++i) sT[i] = 0.f;
#pragma unroll
          for (int ks = 0; ks < 4; ++ks) {
            const bf16x8 a = *(const bf16x8*)(Kb16 + (jt * 32 + r) * 72 + ks * 16 + hh * 8);
            sT = MFMA(a, bqr[ks], sT);
          }
#pragma unroll
          for (int i = 0; i < 16; ++i) {
            const int jl = (i & 3) + 8 * (i >> 2) + 4 * hh;
            const bool valid = (jt < it) || (jl <= r);
            const float dec = valid ? __expf(gci - gcs[jt * 32 + jl]) : 0.f;
            sT[i] *= dec;
          }
#pragma unroll
          for (int sx = 0; sx < 2; ++sx) {
            u32x4 pu;
            pu.x = pack2(sT[8 * sx + 0], sT[8 * sx + 1]); pu.y = pack2(sT[8 * sx + 2], sT[8 * sx + 3]);
            pu.z = pack2(sT[8 * sx + 4], sT[8 * sx + 5]); pu.w = pack2(sT[8 * sx + 6], sT[8 * sx + 7]);
            const u16* vp = CT + r * 72 + jt * 32 + 16 * sx + 4 * hh;
            const uint2 va = *(const uint2*)(vp);
            const uint2 vb2 = *(const uint2*)(vp + 8);
            const u32x4 vu = {va.x, va.y, vb2.x, vb2.y};
            o = MFMA(__builtin_bit_cast(bf16x8, vu), __builtin_bit_cast(bf16x8, pu), o);
          }
        }
        const int pos = c * 64 + it * 32 + r;
        const int tau = dir ? len - 1 - pos : pos;
        u16* op = od + (size_t)(base + tau) * 512 + h * 64 + eb * 32;
#pragma unroll
        for (int g4 = 0; g4 < 4; ++g4) {
          uint2 w;
          w.x = pack2(o[4 * g4 + 0], o[4 * g4 + 1]);
          w.y = pack2(o[4 * g4 + 2], o[4 * g4 + 3]);
          *(uint2*)(op + 8 * g4 + 4 * hh) = w;
        }
      }
      __syncthreads();
    }
  }
  __builtin_amdgcn_s_setprio(0);
}

DI void gla_chain(const P& p, int cid, char* smem) {
  const int e4 = cid & 3, chn = cid >> 2;
  const int dir = chn >> 5, b = (chn >> 2) & 7, h = chn & 3;
  float* qs = (float*)smem;
  float* ks = qs + 4096;
  float* as = ks + 4096;
  float* vs = as + 4096;
  float* ob = vs + 2048;
  const int tid = get_tid(), lane = tid & 63, wave = tid >> 6;
  const u16* z = (const u16*)(p.ws + OFF_REGB);
  const float* alpha = dir == 0 ? (const float*)(p.ws + OFF_KB + (size_t)T * 128 * 2)
                                : (const float*)(p.ws + OFF_REGA + (size_t)LAT * 512 * 2);
  u16* od = (u16*)(p.ws + OFF_ODIR) + (size_t)dir * T * 512;
  __builtin_amdgcn_s_setprio(3);
  f32x2 S[4];
#pragma unroll
  for (int i = 0; i < 4; ++i) S[i] = (f32x2){0.f, 0.f};
  const int dl = lane & 7, ec = wave * 8 + (lane >> 3);
  const int pp = tid >> 2, qd = tid & 3;
  __syncthreads();
  for (int seg = 0; seg < 2; ++seg) {
    const int len = seg == 0 ? CTXL : SEQ;
    const int base = seg == 0 ? LAT + b * CTXL : b * SEQ;
    for (int c = 0; c < len / 64; ++c) {
      {
        const int pos = c * 64 + pp;
        const int tau = dir ? len - 1 - pos : pos;
        const u16* zr = z + (size_t)(base + tau) * ODD_IN;
        float f[16];
        unpack8(*(const uint4*)(zr + h * 64 + qd * 16), f); unpack8(*(const uint4*)(zr + h * 64 + qd * 16 + 8), f + 8);
#pragma unroll
        for (int i = 0; i < 4; ++i)
          *(float4*)(qs + pp * 64 + qd * 16 + i * 4) =
              make_float4(f[4 * i] * 0.125f, f[4 * i + 1] * 0.125f, f[4 * i + 2] * 0.125f, f[4 * i + 3] * 0.125f);
        unpack8(*(const uint4*)(zr + 256 + h * 64 + qd * 16), f); unpack8(*(const uint4*)(zr + 256 + h * 64 + qd * 16 + 8), f + 8);
#pragma unroll
        for (int i = 0; i < 4; ++i)
          *(float4*)(ks + pp * 64 + qd * 16 + i * 4) = make_float4(f[4 * i], f[4 * i + 1], f[4 * i + 2], f[4 * i + 3]);
        const float* ar = alpha + (size_t)(base + tau) * 256 + h * 64 + qd * 16;
#pragma unroll
        for (int i = 0; i < 4; ++i) *(float4*)(as + pp * 64 + qd * 16 + i * 4) = *(const float4*)(ar + i * 4);
        unpack8(*(const uint4*)(zr + 512 + h * 128 + e4 * 32 + qd * 8), f);
        *(float4*)(vs + pp * 32 + qd * 8) = make_float4(f[0], f[1], f[2], f[3]);
        *(float4*)(vs + pp * 32 + qd * 8 + 4) = make_float4(f[4], f[5], f[6], f[7]);
      }
      __syncthreads();
      if (seg == 0) {
#pragma unroll 4
        for (int t = 0; t < 64; ++t) {
          const f32x4v ka = *(const f32x4v*)(ks + t * 64 + dl * 8), kb = *(const f32x4v*)(ks + t * 64 + dl * 8 + 4);
          const f32x4v aa = *(const f32x4v*)(as + t * 64 + dl * 8), ab = *(const f32x4v*)(as + t * 64 + dl * 8 + 4);
          const float v = vs[t * 32 + ec];
          const f32x2 v2 = (f32x2){v, v};
          S[0] = aa.xy * S[0] + ka.xy * v2; S[1] = aa.zw * S[1] + ka.zw * v2;
          S[2] = ab.xy * S[2] + kb.xy * v2; S[3] = ab.zw * S[3] + kb.zw * v2;
        }
        __syncthreads();
      } else {
#define GLA_LOAD(TT, X)                                                                     \
  X##ka = *(const f32x4v*)(ks + (TT) * 64 + dl * 8); X##kb = *(const f32x4v*)(ks + (TT) * 64 + dl * 8 + 4); \
  X##qa = *(const f32x4v*)(qs + (TT) * 64 + dl * 8); X##qb = *(const f32x4v*)(qs + (TT) * 64 + dl * 8 + 4); \
  X##aa = *(const f32x4v*)(as + (TT) * 64 + dl * 8); X##ab = *(const f32x4v*)(as + (TT) * 64 + dl * 8 + 4); \
  X##v = vs[(TT) * 32 + ec];                                                                \
  __builtin_amdgcn_sched_barrier(0);
#define GLA_STEP(U, X)                                                                      \
  {                                                                                         \
    const f32x2 v2 = (f32x2){X##v, X##v};                                                   \
    S[0] = X##aa.xy * S[0] + X##ka.xy * v2; S[1] = X##aa.zw * S[1] + X##ka.zw * v2;         \
    S[2] = X##ab.xy * S[2] + X##kb.xy * v2; S[3] = X##ab.zw * S[3] + X##kb.zw * v2;         \
    f32x2 orr = X##qa.xy * S[0] + X##qa.zw * S[1];                                          \
    orr += X##qb.xy * S[2] + X##qb.zw * S[3];                                               \
    const float ov = row8_sum(orr.x + orr.y);                                               \
    myo = (dl == (U)) ? ov : myo;                                                           \
    __builtin_amdgcn_sched_barrier(0);                                                      \
  }
        f32x4v Aka, Akb, Aqa, Aqb, Aaa, Aab, Bka, Bkb, Bqa, Bqb, Baa, Bab;
        float Av, Bv;
        GLA_LOAD(0, A)
        for (int t0 = 0; t0 < 64; t0 += 8) {
          float myo = 0.f;
          GLA_LOAD(t0 + 1, B) GLA_STEP(0, A)
          GLA_LOAD(t0 + 2, A) GLA_STEP(1, B)
          GLA_LOAD(t0 + 3, B) GLA_STEP(2, A)
          GLA_LOAD(t0 + 4, A) GLA_STEP(3, B)
          GLA_LOAD(t0 + 5, B) GLA_STEP(4, A)
          GLA_LOAD(t0 + 6, A) GLA_STEP(5, B)
          GLA_LOAD(t0 + 7, B) GLA_STEP(6, A)
          GLA_LOAD(t0 + 8, A) GLA_STEP(7, B)
          const int pos = c * 64 + t0 + dl;
          const int tau = dir ? len - 1 - pos : pos;
          od[(size_t)(base + tau) * 512 + h * 128 + e4 * 32 + ec] = f2bf(myo);
        }
        __syncthreads();
      }
    }
  }
  __builtin_amdgcn_s_setprio(0);
}

DI void gla_chain_mfma(const P& p, int cid, char* smem) {
  const int eh = cid & 1, chn = cid >> 1;
  const int dir = chn >> 5, b = (chn >> 2) & 7, h = chn & 3;
  u16* QD = (u16*)smem;
  u16* KI = QD + 64 * 72;
  u16* KDT = KI + 64 * 72;
  u16* VT = KDT + 64 * 72;
  u16* ST = VT + 64 * 72;
  float* BC = (float*)(ST + 64 * 72);
  const int tid = get_tid(), lane = tid & 63, wave = tid >> 6, r = lane & 31, hh = lane >> 5;
  const int et = wave >> 1, it = wave & 1;
  const int pp = tid >> 2, q4 = tid & 3;
  const u16* z = (const u16*)(p.ws + OFF_REGB);
  const float* alpha = dir == 0 ? (const float*)(p.ws + OFF_KB + (size_t)T * 128 * 2)
                                : (const float*)(p.ws + OFF_REGA + (size_t)LAT * 512 * 2);
  u16* od = (u16*)(p.ws + OFF_ODIR) + (size_t)dir * T * 512;
  __syncthreads();
  for (int i = tid; i < 64 * 72 / 2; i += NTHR) ((unsigned*)ST)[i] = 0u;
  f32x16 Sreg;
#pragma unroll
  for (int i = 0; i < 16; ++i) Sreg[i] = 0.f;
  __syncthreads();
  u32x4 rq0, rq1, rk0, rk1, rv0, rv1;
  f32x4v ra0, ra1, ra2, ra3;
#define GLM_RAW(G)                                                                                    \
  {                                                                                                   \
    const int g_ = (G);                                                                               \
    const int sg_ = g_ < 4 ? 0 : 1, c_ = sg_ ? g_ - 4 : g_;                                           \
    const int len_ = sg_ ? SEQ : CTXL, base_ = sg_ ? b * SEQ : LAT + b * CTXL;                        \
    const int pos_ = c_ * 64 + pp;                                                                    \
    const int tau_ = dir ? len_ - 1 - pos_ : pos_;                                                    \
    const u16* zr_ = z + (size_t)(base_ + tau_) * ODD_IN;                                             \
    rq0 = *(const u32x4*)(zr_ + h * 64 + q4 * 16); rq1 = *(const u32x4*)(zr_ + h * 64 + q4 * 16 + 8); \
    rk0 = *(const u32x4*)(zr_ + 256 + h * 64 + q4 * 16); rk1 = *(const u32x4*)(zr_ + 256 + h * 64 + q4 * 16 + 8); \
    rv0 = *(const u32x4*)(zr_ + 512 + h * 128 + eh * 64 + q4 * 16);                                   \
    rv1 = *(const u32x4*)(zr_ + 512 + h * 128 + eh * 64 + q4 * 16 + 8);                               \
    const float* ar_ = alpha + (size_t)(base_ + tau_) * 256 + h * 64 + q4 * 16;                       \
    ra0 = *(const f32x4v*)(ar_); ra1 = *(const f32x4v*)(ar_ + 4); ra2 = *(const f32x4v*)(ar_ + 8); ra3 = *(const f32x4v*)(ar_ + 12); \
  }
  GLM_RAW(0)
  {
    for (int gidx = 0; gidx < 36; ++gidx) {
      const int seg = gidx < 4 ? 0 : 1, c = seg ? gidx - 4 : gidx;
      const int len = seg ? SEQ : CTXL;
      const int base = seg ? b * SEQ : LAT + b * CTXL;
      float qf[16], kf[16];
      {
        unpack8v(rq0, qf); unpack8v(rq1, qf + 8);
        unpack8v(rk0, kf); unpack8v(rk1, kf + 8);
        const f32x4v al[4] = {ra0, ra1, ra2, ra3};
#pragma unroll
        for (int i = 0; i < 4; ++i) {
          BC[pp * 65 + q4 * 16 + i * 4 + 0] = __logf(al[i].x); BC[pp * 65 + q4 * 16 + i * 4 + 1] = __logf(al[i].y);
          BC[pp * 65 + q4 * 16 + i * 4 + 2] = __logf(al[i].z); BC[pp * 65 + q4 * 16 + i * 4 + 3] = __logf(al[i].w);
        }
        const unsigned vw[8] = {rv0.x, rv0.y, rv0.z, rv0.w, rv1.x, rv1.y, rv1.z, rv1.w};
#pragma unroll
        for (int i = 0; i < 8; ++i) {
          VT[(q4 * 16 + 2 * i) * 72 + pp] = (u16)(vw[i] & 0xffffu);
          VT[(q4 * 16 + 2 * i + 1) * 72 + pp] = (u16)(vw[i] >> 16);
        }
        if (gidx + 1 < 36) GLM_RAW(gidx + 1)
      }
      __syncthreads();
      if (tid < 64) {
        float run = 0.f;
#pragma unroll 8
        for (int j = 0; j < 64; ++j) { run += BC[j * 65 + tid]; BC[j * 65 + tid] = run; }
      }
      __syncthreads();
      {
        unsigned wq[8], wk[8];
#pragma unroll
        for (int i = 0; i < 8; ++i) {
          float qv[2], kv2[2];
#pragma unroll
          for (int u = 0; u < 2; ++u) {
            const int d = q4 * 16 + 2 * i + u;
            const float bcv = BC[pp * 65 + d], bl = BC[63 * 65 + d];
            const float e1 = __expf(bcv);
            qv[u] = qf[2 * i + u] * 0.125f * e1;
            kv2[u] = kf[2 * i + u] * __builtin_amdgcn_rcpf(e1);
            KDT[d * 72 + pp] = f2bf(kf[2 * i + u] * __expf(bl - bcv));
          }
          wq[i] = pack2(qv[0], qv[1]);
          wk[i] = pack2(kv2[0], kv2[1]);
        }
        *(u32x4*)(QD + pp * 72 + q4 * 16) = (u32x4){wq[0], wq[1], wq[2], wq[3]};
        *(u32x4*)(QD + pp * 72 + q4 * 16 + 8) = (u32x4){wq[4], wq[5], wq[6], wq[7]};
        *(u32x4*)(KI + pp * 72 + q4 * 16) = (u32x4){wk[0], wk[1], wk[2], wk[3]};
        *(u32x4*)(KI + pp * 72 + q4 * 16 + 8) = (u32x4){wk[4], wk[5], wk[6], wk[7]};
      }
      __syncthreads();
      if (seg == 1) {
        bf16x8 bqf[4];
#pragma unroll
        for (int ks = 0; ks < 4; ++ks) bqf[ks] = *(const bf16x8*)(QD + (it * 32 + r) * 72 + ks * 16 + hh * 8);
        f32x16 o;
#pragma unroll
        for (int i = 0; i < 16; ++i) o[i] = 0.f;
#pragma unroll
        for (int ks = 0; ks < 4; ++ks) {
          const bf16x8 a = *(const bf16x8*)(ST + (et * 32 + r) * 72 + ks * 16 + hh * 8);
          o = MFMA(a, bqf[ks], o);
        }
        for (int jt = 0; jt <= it; ++jt) {
          f32x16 sT;
#pragma unroll
          for (int i = 0; i < 16; ++i) sT[i] = 0.f;
#pragma unroll
          for (int ks = 0; ks < 4; ++ks) {
            const bf16x8 a = *(const bf16x8*)(KI + (jt * 32 + r) * 72 + ks * 16 + hh * 8);
            sT = MFMA(a, bqf[ks], sT);
          }
          if (jt == it) {
#pragma unroll
            for (int i = 0; i < 16; ++i) {
              const int jl = (i & 3) + 8 * (i >> 2) + 4 * hh;
              if (jl > r) sT[i] = 0.f;
            }
          }
#pragma unroll
          for (int sx = 0; sx < 2; ++sx) {
            u32x4 pu;
            pu.x = pack2(sT[8 * sx + 0], sT[8 * sx + 1]); pu.y = pack2(sT[8 * sx + 2], sT[8 * sx + 3]);
            pu.z = pack2(sT[8 * sx + 4], sT[8 * sx + 5]); pu.w = pack2(sT[8 * sx + 6], sT[8 * sx + 7]);
            const u16* vp = VT + (et * 32 + r) * 72 + jt * 32 + 16 * sx + 4 * hh;
            const uint2 va = *(const uint2*)(vp);
            const uint2 vb2 = *(const uint2*)(vp + 8);
            const u32x4 vu = {va.x, va.y, vb2.x, vb2.y};
            o = MFMA(__builtin_bit_cast(bf16x8, vu), __builtin_bit_cast(bf16x8, pu), o);
          }
        }
        const int pos = c * 64 + it * 32 + r;
        const int tau = dir ? len - 1 - pos : pos;
        u16* op = od + (size_t)(base + tau) * 512 + h * 128 + eh * 64 + et * 32;
#pragma unroll
        for (int g4 = 0; g4 < 4; ++g4) {
          uint2 w;
          w.x = pack2(o[4 * g4 + 0], o[4 * g4 + 1]);
          w.y = pack2(o[4 * g4 + 2], o[4 * g4 + 3]);
          *(uint2*)(op + 8 * g4 + 4 * hh) = w;
        }
      }
      {
        f32x16 kvt;
#pragma unroll
        for (int i = 0; i < 16; ++i) kvt[i] = 0.f;
#pragma unroll
        for (int ks = 0; ks < 4; ++ks) {
          const bf16x8 a = *(const bf16x8*)(VT + (et * 32 + r) * 72 + ks * 16 + hh * 8);
          const bf16x8 bk = *(const bf16x8*)(KDT + (it * 32 + r) * 72 + ks * 16 + hh * 8);
          kvt = MFMA(a, bk, kvt);
        }
        const float decay = __expf(BC[63 * 65 + it * 32 + r]);
#pragma unroll
        for (int i = 0; i < 16; ++i) Sreg[i] = Sreg[i] * decay + kvt[i];
      }
      __syncthreads();
#pragma unroll
      for (int i = 0; i < 16; ++i) {
        const int el = (i & 3) + 8 * (i >> 2) + 4 * hh;
        ST[(et * 32 + el) * 72 + it * 32 + r] = f2bf(Sreg[i]);
      }
    }
  }
}

DI void scan_post(const P& p, int layer, int vb, int nvb) {
  const int tid_ = get_tid();
  const int lane = tid_ & 63, wave = tid_ >> 6;
  const u16* z = (const u16*)(p.ws + OFF_REGB);
  u16* o0 = (u16*)(p.ws + OFF_ODIR);
  const u16* o1 = o0 + (size_t)T * 512;
  const int nrows = layer == 0 ? T : LAT;
  const int ldz = layer == 0 ? EVEN_IN : ODD_IN;
  const int goff = layer == 0 ? 2240 : 1056;
  float on[8];
#pragma unroll
  for (int j = 0; j < 8; ++j)
    on[j] = layer == 0 ? p.ev_out_norm[(lane & 7) * 8 + j] : p.od_out_norm[(lane & 15) * 8 + j];
  for (int t = vb * 4 + wave; t < nrows; t += nvb * 4) {
    float a[8], bb[8], gt[8];
    unpack8(*(const uint4*)(o0 + (size_t)t * 512 + lane * 8), a);
    unpack8(*(const uint4*)(o1 + (size_t)t * 512 + lane * 8), bb);
    unpack8(*(const uint4*)(z + (size_t)t * ldz + goff + lane * 8), gt);
    float ss = 0.f;
#pragma unroll
    for (int j = 0; j < 8; ++j) { a[j] += bb[j]; ss += a[j] * a[j]; }
    ss += __shfl_xor(ss, 1); ss += __shfl_xor(ss, 2); ss += __shfl_xor(ss, 4);
    float rms;
    if (layer == 0) rms = rsqrtf(ss * (1.f / 64.f) + EPS);
    else { ss += __shfl_xor(ss, 8); rms = rsqrtf(ss * (1.f / 128.f) + EPS); }
#pragma unroll
    for (int j = 0; j < 8; ++j) a[j] = a[j] * rms * on[j] * silu_f(gt[j]);
    *(uint4*)(o0 + (size_t)t * 512 + lane * 8) = pack8(a);
  }
}


#define XB_TMO      128
#define XB_XCNT(j)  (256  + 64 * (j))
#define XB_XSUB(j)  (1280 + 64 * (j))
#define XB_XGEN(j)  (2304 + 64 * (j))
#define XB_TOP      3328
#define XB_TOPGEN   3392
#define XB_SPIN_CAP (1u << 18)
#define LAS __attribute__((address_space(3)))
DI unsigned xb_ld(unsigned* p) { return __hip_atomic_load(p, __ATOMIC_RELAXED, __HIP_MEMORY_SCOPE_AGENT); }
DI unsigned xb_add(unsigned* p, unsigned v) { return __hip_atomic_fetch_add(p, v, __ATOMIC_RELAXED, __HIP_MEMORY_SCOPE_AGENT); }
DI unsigned xb_xcc_id() { return (unsigned)__builtin_amdgcn_s_getreg((3 << 11) | 20) & 0xFu; }
#define XB_SPIN(cond, bar) do { unsigned _sp = 0; while (cond) { __builtin_amdgcn_s_sleep(1); \
    if ((++_sp & 255u) == 0u) { if (xb_ld(&(bar)[XB_TMO])) break; if (_sp > XB_SPIN_CAP) { atomicAdd(&(bar)[XB_TMO], 1u); break; } } } } while (0)
struct XcdBarrier { unsigned* bar; unsigned x; unsigned G; unsigned nloc; unsigned nx; };
DI XcdBarrier xcd_barrier_post(unsigned* bar, unsigned G, bool member) {
  XcdBarrier b; b.bar = bar; b.x = xb_xcc_id(); b.G = G; b.nloc = 0u; b.nx = 0u;
  if (member && threadIdx.x == 0) (void)xb_add(&bar[XB_XCNT(b.x)], 1u);
  return b;
}
DI void xcd_barrier_complete(unsigned* bar, unsigned x, unsigned G, unsigned& nloc, unsigned& nx) {
  unsigned sum, cnt, mine, sp = 0u;
  for (;;) {
    sum = 0u; cnt = 0u; mine = 0u;
#pragma unroll
    for (unsigned j = 0; j < 16; ++j) { const unsigned c = xb_ld(&bar[XB_XCNT(j)]); sum += c; cnt += (c > 0u) ? 1u : 0u; mine = (j == x) ? c : mine; }
    if (sum == G) break;
    __builtin_amdgcn_s_sleep(1);
    if ((++sp & 255u) == 0u) { if (xb_ld(&bar[XB_TMO])) break; if (sp > XB_SPIN_CAP) { atomicAdd(&bar[XB_TMO], 1u); break; } }
  }
  nloc = mine > 0u ? mine : 1u; nx = cnt > 0u ? cnt : 1u;
}
DI void xcd_barrier(XcdBarrier& b) {
  asm volatile("s_waitcnt vmcnt(0)" ::: "memory");
  __syncthreads();
  if (threadIdx.x == 0) {
    unsigned* bar = b.bar;
    __builtin_amdgcn_s_waitcnt(0);
    unsigned nloc = b.nloc, nx = b.nx;
    if (nloc == 0u) { xcd_barrier_complete(bar, b.x, b.G, nloc, nx); b.nloc = nloc; b.nx = nx; }
    const unsigned old = xb_add(&bar[XB_XSUB(b.x)], 1u);
    const unsigned gen = old / nloc;
    if (old + 1u == (gen + 1u) * nloc) {
      __builtin_amdgcn_fence(__ATOMIC_RELEASE, "agent");
      asm volatile("s_waitcnt vmcnt(0)" ::: "memory");
      const unsigned og = xb_add(&bar[XB_TOP], 1u);
      const unsigned tg = og / nx;
      if (og + 1u == (tg + 1u) * nx) xb_add(&bar[XB_TOPGEN], 1u);
      else XB_SPIN(xb_ld(&bar[XB_TOPGEN]) == tg, bar);
      __builtin_amdgcn_fence(__ATOMIC_ACQUIRE, "agent");
      xb_add(&bar[XB_XGEN(b.x)], 1u);
      asm volatile("s_waitcnt vmcnt(0)" ::: "memory");
    } else {
      XB_SPIN(xb_ld(&bar[XB_XGEN(b.x)]) == gen, bar);
      __builtin_amdgcn_fence(__ATOMIC_ACQUIRE, "agent");
      asm volatile("s_waitcnt vmcnt(0)" ::: "memory");
    }
  }
  __syncthreads();
}

DI void ffn_phases(const P& p, XcdBarrier& xb, int layer, int s, int M, char* smem, int vb, int nvb) {
  char* ws = p.ws;
  {
    GemmDesc g = gemm_simple((const u16*)(ws + OFF_REGA), 1024, (const u16*)(ws + OFF_WGU) + (size_t)s * 5632 * 1024,
                             1024, M, 5632);
    g.o16 = (u16*)(ws + OFF_REGB); g.ldo = DFF;
    gemm_auto<EPI_SWIGLU>(g, M, smem, vb, nvb);
  }
  xcd_barrier(xb);
  {
    GemmDesc g = gemm_simple((const u16*)(ws + OFF_REGB), DFF, (const u16*)(ws + OFF_WDN) + (size_t)s * 1024 * 2816,
                             DFF, M, 1024);
    g.xres = p.out; g.hres = (float*)(ws + OFF_RH);
    g.mod = (const float*)(ws + OFF_MODS) + (size_t)layer * 9 * 9216;
    g.gidx = s == 0 ? 2 : 8; g.coef = 0.5f;
    gemm_auto<EPI_RES>(g, M, smem, vb, nvb);
  }
  xcd_barrier(xb);
}

__global__ void __launch_bounds__(NTHR, 2) mega(P p) {
  extern __shared__ __attribute__((aligned(16))) char smem[];
  cg::grid_group grid = cg::this_grid();
  const int vb = blockIdx.x, nvb = gridDim.x;
  char* ws = p.ws;
  XcdBarrier xb = xcd_barrier_post((unsigned*)(ws + OFF_BAR), gridDim.x, true);
  const bool subgrid = nvb >= 512;
  XcdBarrier xb2 = xcd_barrier_post((unsigned*)(ws + OFF_BAR) + 4096, gridDim.x - 256, subgrid && vb >= 256);
  if (p.ws == nullptr) grid.sync();

  mods_phase(p, smem, vb, nvb);
  __syncthreads();
  convert_weights(p, 0, smem, vb, nvb, 0);
  convert_weights(p, 0, smem, vb, nvb, 1);
  xcd_barrier(xb);

  for (int layer = 0; layer < 2; ++layer) {
    const bool ctx_out = layer == 0;
    if (layer == 1) convert_weights(p, 1, smem, vb, nvb, 0);
    normmod_phase(p, layer, 0, T, layer == 0, vb, nvb);
    xcd_barrier(xb);
    ffn_phases(p, xb, layer, 0, T, smem, vb, nvb);
    normmod_phase(p, layer, 1, T, false, vb, nvb);
    xcd_barrier(xb);
    {
      GemmDesc g = gemm_simple((const u16*)(ws + OFF_REGA), 1024, (const u16*)(ws + OFF_WIN), 1024, T,
                               layer == 0 ? EVEN_PAD : ODD_PAD);
      g.o16 = (u16*)(ws + OFF_REGB);
      g.ldo = layer == 0 ? EVEN_IN : ODD_IN;
      g.nreal = g.ldo;
      g.side = (float*)(ws + OFF_SIDE);
      g.slo = layer == 0 ? 2208 : 1024;
      gemm_auto<EPI_STORE>(g, T, smem, vb, nvb);
    }
    xcd_barrier(xb);
    if (layer == 0) {
      const bool split0 = subgrid;
      const int svb = split0 ? vb - 256 : vb, snvb = split0 ? nvb - 256 : nvb;
      if (!split0 || vb < 256)
        for (int cid = vb; cid < 256; cid += (split0 ? 256 : nvb)) gdn_chain(p, cid, smem);
      __syncthreads();
      if (!split0 || vb >= 256) {
        XcdBarrier& bs = split0 ? xb2 : xb;
        {
          GemmDesc g = gemm_simple((const u16*)(ws + OFF_REGB), EVEN_IN, (const u16*)(ws + OFF_WQUP), 384, T, 768);
          g.o16 = (u16*)(ws + OFF_QB); g.ldo = 768; g.nreal = 768;
          gemm_auto<EPI_STORE>(g, T, smem, svb, snvb);
          GemmDesc g2 = gemm_simple((const u16*)(ws + OFF_REGB) + 384, EVEN_IN, (const u16*)(ws + OFF_WKVUP), 256, T, 1024);
          g2.o16 = (u16*)(ws + OFF_REGA); g2.ldo = 1024; g2.nreal = 1024;
          gemm_auto<EPI_STORE>(g2, T, smem, svb, snvb);
        }
        xcd_barrier(bs);
        mla_finalize(p, smem, svb, snvb);
        xcd_barrier(bs);
        const u16* Q = (const u16*)(ws + OFF_QB);
        const u16* Kb = (const u16*)(ws + OFF_KB);
        const u16* KV = (const u16*)(ws + OFF_REGA);
        for (int it = svb; it < 1024 + 128; it += snvb) {
          if (it < 1024) {
            const int b = it >> 7, h = (it >> 4) & 7, qt = it & 15;
            attn_item<96, false>(Q, 768, h * 96, Kb, 768, h * 96, KV, 1024, h * 128 + 64, b * SEQ + qt * 128, qt * 128,
                                 LAT + b * CTXL, b * SEQ, 0, 32, 0.f, (u16*)(ws + OFF_QB), 768, h * 96, smem);
          } else {
            const int j = it - 1024;
            const int b = j >> 4, h = (j >> 1) & 7, qt = j & 1;
            attn_item<96, false>(Q, 768, h * 96, Kb, 768, h * 96, KV, 1024, h * 128 + 64, LAT + b * CTXL + qt * 128, 0,
                                 LAT + b * CTXL, b * SEQ, 0, 0, 0.f, (u16*)(ws + OFF_QB), 768, h * 96, smem);
          }
        }
      }
      xcd_barrier(xb);
      scan_post(p, 0, vb, nvb);
      xcd_barrier(xb);
      {
        GemmDesc g = gemm_simple((const u16*)(ws + OFF_QB), 768, (const u16*)(ws + OFF_WOUT), 1024, T, 1024);
        g.kstep0 = 96; g.ksplit = 8; g.A1 = (const u16*)(ws + OFF_ODIR); g.lda1 = 512;
        g.xres = p.out; g.hres = (float*)(ws + OFF_RH);
        g.mod = (const float*)(ws + OFF_MODS); g.gidx = 5; g.coef = 1.f;
        gemm_auto<EPI_RES>(g, T, smem, vb, nvb);
      }
      xcd_barrier(xb);
    } else {
      swa_finalize(p, smem, vb, nvb);
      xcd_barrier(xb);
      const bool split1 = nvb >= 256;
      if (!split1 || vb < 128)
        for (int cid = vb; cid < 128; cid += (split1 ? 128 : nvb)) gla_chain_mfma(p, cid, smem);
      __syncthreads();
      if (!split1 || vb >= 128)
      {
        const u16* Q = (const u16*)(ws + OFF_QB);
        const u16* Kb = (const u16*)(ws + OFF_KB);
        const u16* z = (const u16*)(ws + OFF_REGB);
        for (int it = (split1 ? vb - 128 : vb); it < 1024; it += (split1 ? nvb - 128 : nvb)) {
          const int b = it >> 7, h = (it >> 4) & 7, qt = it & 15;
          const int g2 = h >> 2;
          const int q0 = qt * 128;
          const int lo = (q0 - 128 < 0 ? 0 : q0 - 128) >> 6;
          const int hi = (q0 + 256 > SEQ ? SEQ : q0 + 256) >> 6;
          attn_item<64, true>(Q, 512, h * 64, Kb, 128, g2 * 64, z, ODD_IN, 2208 + g2 * 64, b * SEQ + q0, q0,
                              LAT + b * CTXL, b * SEQ, lo, hi, p.od_sink[h] * LOG2E, (u16*)(ws + OFF_REGA), 512, h * 64,
                              smem);
        }
        __syncthreads();
        convert_weights(p, 1, smem, split1 ? vb - 128 : vb, split1 ? nvb - 128 : nvb, 1);
      }
      xcd_barrier(xb);
      scan_post(p, 1, vb, nvb);
      xcd_barrier(xb);
      {
        GemmDesc g = gemm_simple((const u16*)(ws + OFF_ODIR), 512, (const u16*)(ws + OFF_WOUT), 1024, LAT, 1024);
        g.kstep0 = 64; g.ksplit = 8; g.A1 = (const u16*)(ws + OFF_REGA); g.lda1 = 512;
        g.xres = p.out; g.hres = (float*)(ws + OFF_RH);
        g.mod = (const float*)(ws + OFF_MODS) + (size_t)9 * 9216; g.gidx = 5; g.coef = 1.f;
        gemm_auto<EPI_RES>(g, LAT, smem, vb, nvb);
      }
      xcd_barrier(xb);
    }
    const int M2 = ctx_out ? T : LAT;
    normmod_phase(p, layer, 2, M2, false, vb, nvb);
    xcd_barrier(xb);
    ffn_phases(p, xb, layer, 1, M2, smem, vb, nvb);
  }
}

extern "C" void kernel_launch(void* const* d_in, const int* in_sizes, int n_in, void* d_out, int out_size, void* d_ws,
                              size_t ws_size, hipStream_t stream) {
  static int grid_blocks = 0;
  if (!grid_blocks) {
    int dev = 0, cus = 0, per_cu = 0;
    hipGetDevice(&dev);
    hipDeviceGetAttribute(&cus, hipDeviceAttributeMultiprocessorCount, dev);
    hipFuncSetAttribute((const void*)mega, hipFuncAttributeMaxDynamicSharedMemorySize, SMEM_BYTES);
    hipOccupancyMaxActiveBlocksPerMultiprocessor(&per_cu, mega, NTHR, SMEM_BYTES);
    if (per_cu > 2) per_cu = 2;
    grid_blocks = cus * per_cu;
    if (ws_size < WS_NEED) fprintf(stderr, "workspace too small: %zu < %zu\n", ws_size, (size_t)WS_NEED);
  }
  P p{};
  const float* const* in = (const float* const*)d_in;
  p.x = in[0]; p.c = in[1]; p.ctx = in[2]; p.c_ctx = in[3]; p.ada_w = in[4]; p.ada_b = in[5]; p.norm_g = in[6];
  p.ffn_g = in[7]; p.ffn_u = in[8]; p.ffn_d = in[9];
  p.ev_w_in = in[10]; p.ev_q_a_norm = in[11]; p.ev_w_q_up = in[12]; p.ev_kv_a_norm = in[13]; p.ev_w_kv_up = in[14];
  p.ev_q_norm = in[15]; p.ev_k_norm = in[16]; p.ev_conv = in[17]; p.ev_a_log = in[18]; p.ev_dt_bias = in[19];
  p.ev_out_norm = in[20]; p.ev_w_out = in[21];
  p.od_w_in = in[22]; p.od_w2 = in[23]; p.od_gb = in[24]; p.od_out_norm = in[25]; p.od_q_norm = in[26];
  p.od_k_norm = in[27]; p.od_sink = in[28]; p.od_w_out = in[29];
  p.out = (float*)d_out;
  p.ws = (char*)d_ws;
  hipMemsetAsync((char*)d_ws + OFF_BAR, 0, 32768, stream);
  void* args[] = {&p};
  hipError_t e = hipLaunchCooperativeKernel((const void*)mega, dim3(grid_blocks), dim3(NTHR), args, SMEM_BYTES, stream);
  if (e != hipSuccess) fprintf(stderr, "cooperative launch failed: %s (grid %d)\n", hipGetErrorString(e), grid_blocks);
}
```

```cpp
#include <hip/hip_runtime.h>
#include <hip/hip_cooperative_groups.h>
#include <cstdio>
namespace cg = cooperative_groups;

#define DI __device__ __forceinline__
typedef unsigned short u16;
typedef short bf16x8 __attribute__((ext_vector_type(8)));
typedef float f32x16 __attribute__((ext_vector_type(16)));
typedef unsigned u32x4 __attribute__((ext_vector_type(4)));
typedef float f32x2 __attribute__((ext_vector_type(2)));
typedef float f32x4v __attribute__((ext_vector_type(4)));
#define LAS3 __attribute__((address_space(3)))
#define MFMA(a, b, c) __builtin_amdgcn_mfma_f32_32x32x16_bf16((a), (b), (c), 0, 0, 0)

constexpr int D = 1024, NB = 8, SEQ = 2048, CTXL = 256;
constexpr int LAT = NB * SEQ, NCTX = NB * CTXL, T = LAT + NCTX;
constexpr int DFF = 2816;
constexpr int EVEN_IN = 2752, EVEN_PAD = 2816, ODD_IN = 2336, ODD_PAD = 2432;
constexpr float EPS = 1e-6f;
constexpr float LOG2E = 1.4426950408889634f;
constexpr int NTHR = 256;
constexpr int SMEM_BYTES = 81920;

constexpr size_t OFF_WGU = 0;
constexpr size_t OFF_WDN = OFF_WGU + 2ull * 5632 * 1024 * 2;
constexpr size_t OFF_WIN = OFF_WDN + 2ull * 1024 * 2816 * 2;
constexpr size_t OFF_WQUP = OFF_WIN + 2816ull * 1024 * 2;
constexpr size_t OFF_WKVUP = OFF_WQUP + 768ull * 384 * 2;
constexpr size_t OFF_WOUT = OFF_WKVUP + 1024ull * 256 * 2;
constexpr size_t OFF_MODS = OFF_WOUT + 1024ull * 1024 * 2;
constexpr size_t OFF_RH = OFF_MODS + 2ull * 9 * 9216 * 4;
constexpr size_t OFF_SIDE = OFF_RH + 2048ull * 1024 * 4;
constexpr size_t OFF_REGA = OFF_SIDE + (size_t)T * 32 * 4;
constexpr size_t OFF_REGB = OFF_REGA + (size_t)T * 1024 * 2;
constexpr size_t OFF_QB = OFF_REGB + (size_t)T * 2816 * 2;
constexpr size_t OFF_KB = OFF_QB + (size_t)T * 768 * 2;
constexpr size_t OFF_ODIR = OFF_KB + (size_t)T * 768 * 2;
constexpr size_t OFF_BAR = OFF_ODIR + 2ull * T * 512 * 2;
constexpr size_t WS_NEED = OFF_BAR + 32768;

struct P {
  const float *x, *c, *ctx, *c_ctx, *ada_w, *ada_b, *norm_g, *ffn_g, *ffn_u, *ffn_d;
  const float *ev_w_in, *ev_q_a_norm, *ev_w_q_up, *ev_kv_a_norm, *ev_w_kv_up, *ev_q_norm, *ev_k_norm, *ev_conv,
      *ev_a_log, *ev_dt_bias, *ev_out_norm, *ev_w_out;
  const float *od_w_in, *od_w2, *od_gb, *od_out_norm, *od_q_norm, *od_k_norm, *od_sink, *od_w_out;
  float* out;
  char* ws;
};

DI int get_tid() {
  int t = threadIdx.x;
  asm volatile("" : "+v"(t));
  return t;
}
DI u16 f2bf(float x) {
  return __builtin_bit_cast(u16, (__bf16)x);
}
DI float bf2f(u16 v) { return __uint_as_float(((unsigned)v) << 16); }
typedef __bf16 bf16x2v __attribute__((ext_vector_type(2)));
DI unsigned pack2(float a, float b) {
  const f32x2 v = {a, b};
  return __builtin_bit_cast(unsigned, __builtin_convertvector(v, bf16x2v));
}
DI float bflo(unsigned w) { return __uint_as_float(w << 16); }
DI float bfhi(unsigned w) { return __uint_as_float(w & 0xffff0000u); }
DI void unpack8(uint4 v, float* f) {
  f[0] = bflo(v.x); f[1] = bfhi(v.x); f[2] = bflo(v.y); f[3] = bfhi(v.y);
  f[4] = bflo(v.z); f[5] = bfhi(v.z); f[6] = bflo(v.w); f[7] = bfhi(v.w);
}
DI void unpack8v(u32x4 v, float* f) {
  f[0] = bflo(v.x); f[1] = bfhi(v.x); f[2] = bflo(v.y); f[3] = bfhi(v.y);
  f[4] = bflo(v.z); f[5] = bfhi(v.z); f[6] = bflo(v.w); f[7] = bfhi(v.w);
}
DI uint4 pack8(const float* f) {
  uint4 v;
  v.x = pack2(f[0], f[1]); v.y = pack2(f[2], f[3]); v.z = pack2(f[4], f[5]); v.w = pack2(f[6], f[7]);
  return v;
}
DI float wave_sum(float v) {
  v += __shfl_xor(v, 32); v += __shfl_xor(v, 16); v += __shfl_xor(v, 8);
  v += __shfl_xor(v, 4); v += __shfl_xor(v, 2); v += __shfl_xor(v, 1);
  return v;
}
DI float quad_sum(float v) {
  v += __builtin_bit_cast(float, __builtin_amdgcn_mov_dpp(__builtin_bit_cast(int, v), 0xB1, 0xF, 0xF, true));
  v += __builtin_bit_cast(float, __builtin_amdgcn_mov_dpp(__builtin_bit_cast(int, v), 0x4E, 0xF, 0xF, true));
  return v;
}
DI float row16_sum(float v) {
  v += __builtin_bit_cast(float, __builtin_amdgcn_mov_dpp(__builtin_bit_cast(int, v), 0xB1, 0xF, 0xF, true));
  v += __builtin_bit_cast(float, __builtin_amdgcn_mov_dpp(__builtin_bit_cast(int, v), 0x4E, 0xF, 0xF, true));
  v += __builtin_bit_cast(float, __builtin_amdgcn_mov_dpp(__builtin_bit_cast(int, v), 0x141, 0xF, 0xF, true));
  v += __builtin_bit_cast(float, __builtin_amdgcn_mov_dpp(__builtin_bit_cast(int, v), 0x140, 0xF, 0xF, true));
  return v;
}
DI float row8_sum(float v) {
  v += __builtin_bit_cast(float, __builtin_amdgcn_mov_dpp(__builtin_bit_cast(int, v), 0xB1, 0xF, 0xF, true));
  v += __builtin_bit_cast(float, __builtin_amdgcn_mov_dpp(__builtin_bit_cast(int, v), 0x4E, 0xF, 0xF, true));
  v += __builtin_bit_cast(float, __builtin_amdgcn_mov_dpp(__builtin_bit_cast(int, v), 0x141, 0xF, 0xF, true));
  return v;
}
DI void wave_lds_sync() {
  asm volatile("s_waitcnt lgkmcnt(0)" ::: "memory");
  __builtin_amdgcn_wave_barrier();
}
DI float silu_f(float x) { return x * __builtin_amdgcn_rcpf(1.f + __expf(-x)); }
DI float sigmoid_f(float x) { return __builtin_amdgcn_rcpf(1.f + __expf(-x)); }
DI float softplus_f(float x) { return x > 20.f ? x : log1pf(__expf(x)); }

DI void conv_tile(const float* __restrict__ src, int N, u16* __restrict__ dst, int ldd, int k0, int n0, int mode,
                  const float* __restrict__ kscale, float* tl) {
  const int t = get_tid();
  const int r = t >> 4, c4 = (t & 15) * 4;
#pragma unroll
  for (int i = 0; i < 4; ++i) {
    const int k = r + 16 * i;
    float4 v = make_float4(0.f, 0.f, 0.f, 0.f);
    if (n0 + c4 < N) v = *(const float4*)(src + (size_t)(k0 + k) * N + n0 + c4);
    if (kscale) { const float s = kscale[k0 + k]; v.x *= s; v.y *= s; v.z *= s; v.w *= s; }
    float* q = tl + k * 65 + c4;
    q[0] = v.x; q[1] = v.y; q[2] = v.z; q[3] = v.w;
  }
  __syncthreads();
  const int n = t >> 2, ks = (t & 3) * 16;
  unsigned w[8];
#pragma unroll
  for (int j = 0; j < 8; ++j) w[j] = pack2(tl[(ks + 2 * j) * 65 + n], tl[(ks + 2 * j + 1) * 65 + n]);
  const int nn = n0 + n;
  const int drow = mode == 0 ? nn : ((nn >> 5) * 64 + (nn & 31) + (mode == 2 ? 32 : 0));
  uint4* d = (uint4*)(dst + (size_t)drow * ldd + k0 + ks);
  d[0] = make_uint4(w[0], w[1], w[2], w[3]);
  d[1] = make_uint4(w[4], w[5], w[6], w[7]);
  __syncthreads();
}

DI void convert_weights(const P& p, int layer, char* smem, int vb, int nvb, int part) {
  float* tl = (float*)smem;
  char* ws = p.ws;
  const int nFF = 704;
  const int nIn = (layer == 0 ? EVEN_PAD : ODD_PAD) / 64 * 16;
  const int nQ = layer == 0 ? 72 : 0, nKV = layer == 0 ? 64 : 0;
  const int nEarly = 3 * nFF + nIn + nQ + nKV, nLate = 3 * nFF + 256;
  const int total = part == 0 ? nEarly : nLate;
  for (int job = vb; job < total; job += nvb) {
    int j = part == 0 ? (job < 3 * nFF ? job : job + 3 * nFF)
                      : (job < 3 * nFF ? job + 3 * nFF : 6 * nFF + nIn + nQ + nKV + (job - 3 * nFF));
    if (j < 6 * nFF) {
      const int s = j / (3 * nFF);
      int jj = j % (3 * nFF);
      const int which = jj / nFF;
      jj %= nFF;
      const size_t woff = ((size_t)layer * 2 + s) * 1024 * 2816;
      if (which < 2) {
        const float* src = (which == 0 ? p.ffn_g : p.ffn_u) + woff;
        u16* dst = (u16*)(ws + OFF_WGU) + (size_t)s * 5632 * 1024;
        conv_tile(src, 2816, dst, 1024, (jj / 44) * 64, (jj % 44) * 64, 1 + which, nullptr, tl);
      } else {
        const float* src = p.ffn_d + woff;
        u16* dst = (u16*)(ws + OFF_WDN) + (size_t)s * 1024 * 2816;
        conv_tile(src, 1024, dst, 2816, (jj / 16) * 64, (jj % 16) * 64, 0, nullptr, tl);
      }
      continue;
    }
    j -= 6 * nFF;
    if (j < nIn) {
      const int N = layer == 0 ? EVEN_IN : ODD_IN;
      const int ntn = (layer == 0 ? EVEN_PAD : ODD_PAD) / 64;
      const float* src = layer == 0 ? p.ev_w_in : p.od_w_in;
      conv_tile(src, N, (u16*)(ws + OFF_WIN), 1024, (j / ntn) * 64, (j % ntn) * 64, 0, nullptr, tl);
      continue;
    }
    j -= nIn;
    if (j < nQ) {
      conv_tile(p.ev_w_q_up, 768, (u16*)(ws + OFF_WQUP), 384, (j / 12) * 64, (j % 12) * 64, 0, p.ev_q_a_norm, tl);
      continue;
    }
    j -= nQ;
    if (j < nKV) {
      conv_tile(p.ev_w_kv_up, 1024, (u16*)(ws + OFF_WKVUP), 256, (j / 16) * 64, (j % 16) * 64, 0, p.ev_kv_a_norm, tl);
      continue;
    }
    j -= nKV;
    {
      const float* src = layer == 0 ? p.ev_w_out : p.od_w_out;
      conv_tile(src, 1024, (u16*)(ws + OFF_WOUT), 1024, (j / 16) * 64, (j % 16) * 64, 0, nullptr, tl);
    }
  }
}

DI void mods_phase(const P& p, char* smem, int vb, int nvb) {
  float* sc = (float*)smem;
  float* red = sc + 9 * 1024;
  float* mods = (float*)(p.ws + OFF_MODS);
  const int t = get_tid();
  bool loaded = false;
  for (int job = vb; job < 576; job += nvb) {
    if (!loaded) {
      for (int i = t; i < 9 * 1024; i += NTHR) {
        const float v = i < 8192 ? p.c[i] : p.c_ctx[i - 8192];
        sc[i] = silu_f(v);
      }
      loaded = true;
      __syncthreads();
    }
    const int l = job / 288, n0 = (job % 288) * 32;
    const int c4 = (t & 7) * 4, ksl = t >> 3;
    float4 acc[9];
#pragma unroll
    for (int r = 0; r < 9; ++r) acc[r] = make_float4(0.f, 0.f, 0.f, 0.f);
    const float* w = p.ada_w + (size_t)l * 1024 * 9216 + n0 + c4;
#pragma unroll 8
    for (int kk = 0; kk < 32; ++kk) {
      const int k = ksl * 32 + kk;
      const float4 wv = *(const float4*)(w + (size_t)k * 9216);
#pragma unroll
      for (int r = 0; r < 9; ++r) {
        const float sv = sc[r * 1024 + k];
        acc[r].x += sv * wv.x; acc[r].y += sv * wv.y; acc[r].z += sv * wv.z; acc[r].w += sv * wv.w;
      }
    }
#pragma unroll
    for (int r = 0; r < 9; ++r) *(float4*)(red + (ksl * 9 + r) * 32 + c4) = acc[r];
    __syncthreads();
    for (int i = t; i < 9 * 32; i += NTHR) {
      const int r = i >> 5, cc = i & 31;
      float v = p.ada_b[(size_t)l * 9216 + n0 + cc];
#pragma unroll
      for (int sl = 0; sl < 32; ++sl) v += red[(sl * 9 + r) * 32 + cc];
      mods[((size_t)l * 9 + r) * 9216 + n0 + cc] = v;
    }
    __syncthreads();
  }
}

DI void normmod_phase(const P& p, int layer, int which, int nrows, bool first, int vb, int nvb) {
  const int tid_ = get_tid();
  const int lane = tid_ & 63, wave = tid_ >> 6;
  u16* dst = (u16*)(p.ws + OFF_REGA);
  float* rh = (float*)(p.ws + OFF_RH);
  const float* mods = (const float*)(p.ws + OFF_MODS) + (size_t)layer * 9 * 9216;
  const float* g = p.norm_g + ((size_t)layer * 3 + which) * 1024;
  const int shift_i = which * 3, scale_i = which * 3 + 1;
  const int nw = nvb * 4;
  const int per = (nrows + nw - 1) / nw;
  const int row0 = (vb * 4 + wave) * per;
  const int row1 = row0 + per < nrows ? row0 + per : nrows;
  f32x4v gg[4], sh[4], sc1[4];
#pragma unroll
  for (int i = 0; i < 4; ++i) {
    gg[i] = *(const f32x4v*)(g + i * 256 + lane * 4);
    sh[i] = (f32x4v){0.f, 0.f, 0.f, 0.f};
    sc1[i] = (f32x4v){1.f, 1.f, 1.f, 1.f};
  }
  int crg = -1;
  for (int row = row0; row < row1; ++row) {
    const float* src;
    float* res = row < LAT ? p.out + (size_t)row * 1024 : rh + (size_t)(row - LAT) * 1024;
    if (first) src = row < LAT ? p.x + (size_t)row * 1024 : p.ctx + (size_t)(row - LAT) * 1024;
    else src = res;
    const int rg = row < LAT ? (row >> 11) : 8;
    if (rg != crg) {
      const float* mrow = mods + (size_t)rg * 9216;
#pragma unroll
      for (int i = 0; i < 4; ++i) {
        sh[i] = *(const f32x4v*)(mrow + shift_i * 1024 + i * 256 + lane * 4);
        sc1[i] = *(const f32x4v*)(mrow + scale_i * 1024 + i * 256 + lane * 4) + 1.f;
        sc1[i] *= gg[i];
      }
      crg = rg;
    }
    f32x4v v[4];
    float ss = 0.f;
#pragma unroll
    for (int i = 0; i < 4; ++i) {
      v[i] = *(const f32x4v*)(src + i * 256 + lane * 4);
      ss += v[i].x * v[i].x + v[i].y * v[i].y + v[i].z * v[i].z + v[i].w * v[i].w;
    }
    ss = wave_sum(ss);
    const float rinv = rsqrtf(ss * (1.f / 1024.f) + EPS);
#pragma unroll
    for (int i = 0; i < 4; ++i) {
      const int col = i * 256 + lane * 4;
      if (first) *(f32x4v*)(res + col) = v[i];
      const f32x4v y = v[i] * rinv * sc1[i] + sh[i];
      uint2 o;
      o.x = pack2(y.x, y.y); o.y = pack2(y.z, y.w);
      *(uint2*)(dst + (size_t)row * 1024 + col) = o;
    }
  }
}

struct GemmDesc {
  const u16* A0; int lda0; int kstep0; int ksplit;
  const u16* A1; int lda1;
  const u16* Bt; int K; int nM; int nN;
  u16* o16; int ldo; int nreal; float* side; int slo;
  float* xres; float* hres; const float* mod; int gidx; float coef;
};
constexpr int EPI_SWIGLU = 0, EPI_RES = 1, EPI_STORE = 2;

template <int EPI, int MI>
DI void gemm_tile(const GemmDesc& g, int tm, int tn, char* smem) {
  constexpr int BM = 64 * MI, ABYTES = BM * 128;
  char* As = smem;
  char* Bs = smem + 2 * ABYTES;
  const int tid = get_tid(), lane = tid & 63, wave = tid >> 6, r = lane & 31, hh = lane >> 5;
  const int wm = wave >> 1, wn = wave & 1;
  const int m0 = tm * BM, n0 = tn * 128;
  const int nk = g.K >> 6;
  f32x16 acc[MI][2];
#pragma unroll
  for (int a = 0; a < MI; ++a)
#pragma unroll
    for (int b = 0; b < 2; ++b)
#pragma unroll
      for (int i = 0; i < 16; ++i) acc[a][b][i] = 0.f;
  const int srow = tid >> 3;
  const int schunk = (tid & 7) ^ ((srow & 7) ^ ((srow >> 3) & 3));
#define G_GLDS(KT, BUF)                                                                               \
  {                                                                                                   \
    const int kt_ = (KT);                                                                             \
    const u16* Ab_; int lda_;                                                                         \
    if (kt_ < g.ksplit) { Ab_ = g.A0 + kt_ * g.kstep0; lda_ = g.lda0; }                              \
    else { Ab_ = g.A1 + (kt_ - g.ksplit) * 64; lda_ = g.lda1; }                                       \
    const u16* pa_ = Ab_ + (size_t)(m0 + srow) * lda_ + schunk * 8;                                   \
    const u16* pb_ = g.Bt + (size_t)(n0 + srow) * g.K + kt_ * 64 + schunk * 8;                        \
    char* la_ = As + (BUF) * ABYTES + tid * 16;                                                       \
    char* lb_ = Bs + (BUF) * 16384 + tid * 16;                                                        \
    _Pragma("unroll") for (int i = 0; i < 2 * MI; ++i)                                                \
      __builtin_amdgcn_global_load_lds((const unsigned*)(pa_ + (size_t)(32 * i) * lda_),             \
                                       (LAS3 unsigned*)(la_ + i * 4096), 16, 0, 0);                   \
    _Pragma("unroll") for (int i = 0; i < 4; ++i)                                                     \
      __builtin_amdgcn_global_load_lds((const unsigned*)(pb_ + (size_t)(32 * i) * g.K),              \
                                       (LAS3 unsigned*)(lb_ + i * 4096), 16, 0, 0);                   \
  }
  const int rowA = wm * (32 * MI) + r, rowB = wn * 64 + r;
  const int hk = hh ^ ((r & 7) ^ ((r >> 3) & 3));
#define G_COMPUTE(BUF)                                                                                \
  {                                                                                                   \
    const char* Ab = As + (BUF) * ABYTES + rowA * 128;                                                \
    const char* Bb = Bs + (BUF) * 16384 + rowB * 128;                                                 \
    _Pragma("unroll") for (int ks = 0; ks < 4; ++ks) {                                                \
      const int oc = (hk ^ (ks * 2)) << 4;                                                            \
      const bf16x8 b0 = *(const bf16x8*)(Bb + oc);                                                    \
      const bf16x8 b1 = *(const bf16x8*)(Bb + 32 * 128 + oc);                                         \
      _Pragma("unroll") for (int mi = 0; mi < MI; ++mi) {                                             \
        const bf16x8 a0 = *(const bf16x8*)(Ab + mi * 32 * 128 + oc);                                  \
        acc[mi][0] = MFMA(a0, b0, acc[mi][0]);                                                        \
        acc[mi][1] = MFMA(a0, b1, acc[mi][1]);                                                        \
      }                                                                                               \
    }                                                                                                 \
  }
  G_GLDS(0, 0);
  asm volatile("s_waitcnt vmcnt(0)" ::: "memory");
  __syncthreads();
  for (int kt = 0; kt < nk; kt += 2) {
    if (kt + 1 < nk) G_GLDS(kt + 1, 1);
    G_COMPUTE(0);
    asm volatile("s_waitcnt vmcnt(0)" ::: "memory");
    __syncthreads();
    if (kt + 1 < nk) {
      if (kt + 2 < nk) G_GLDS(kt + 2, 0);
      G_COMPUTE(1);
      asm volatile("s_waitcnt vmcnt(0)" ::: "memory");
      __syncthreads();
    }
  }
#undef G_GLDS
#undef G_COMPUTE
  if (EPI == EPI_SWIGLU) {
    u16* es = (u16*)smem;
#pragma unroll
    for (int mi = 0; mi < MI; ++mi)
#pragma unroll
      for (int i = 0; i < 16; ++i) {
        const int lrow = wm * (32 * MI) + mi * 32 + (i & 3) + 8 * (i >> 2) + 4 * hh;
        es[lrow * 64 + wn * 32 + r] = f2bf(silu_f(acc[mi][0][i]) * acc[mi][1][i]);
      }
    __syncthreads();
#pragma unroll
    for (int j = 0; j < 2 * MI; ++j) {
      const int lrow = (tid >> 3) + 32 * j, ch = tid & 7;
      const u32x4 v = *(const u32x4*)(es + lrow * 64 + ch * 8);
      *(u32x4*)(g.o16 + (size_t)(m0 + lrow) * g.ldo + (n0 >> 1) + ch * 8) = v;
    }
    __syncthreads();
  } else if (EPI == EPI_RES) {
    float* es = (float*)smem;
    const int c4 = (tid & 31) * 4;
    const int rgA = m0 < LAT ? (m0 >> 11) : 8;
    const int mlast = m0 + BM - 1;
    const int rgB = mlast < LAT ? (mlast >> 11) : 8;
    const f32x4v m4a = *(const f32x4v*)(g.mod + (size_t)rgA * 9216 + g.gidx * 1024 + n0 + c4);
    const f32x4v m4b = *(const f32x4v*)(g.mod + (size_t)rgB * 9216 + g.gidx * 1024 + n0 + c4);
#pragma unroll
    for (int mi = 0; mi < MI; ++mi) {
#pragma unroll
      for (int ni = 0; ni < 2; ++ni)
#pragma unroll
        for (int i = 0; i < 16; ++i) {
          const int lrow = wm * 32 + (i & 3) + 8 * (i >> 2) + 4 * hh;
          es[lrow * 128 + wn * 64 + ni * 32 + r] = acc[mi][ni][i];
        }
      __syncthreads();
#pragma unroll 4
      for (int j = 0; j < 8; ++j) {
        const int lrow = (tid >> 5) + 8 * j;
        const int grow = m0 + (lrow >> 5) * (32 * MI) + mi * 32 + (lrow & 31);
        const f32x4v a4 = *(const f32x4v*)(es + lrow * 128 + c4);
        const int rg = grow < LAT ? (grow >> 11) : 8;
        const f32x4v m4 = rg == rgA ? m4a : m4b;
        float* rp = (grow < LAT ? g.xres + (size_t)grow * 1024 : g.hres + (size_t)(grow - LAT) * 1024) + n0 + c4;
        f32x4v x4 = *(const f32x4v*)rp;
        x4 += (m4 * a4) * g.coef;
        *(f32x4v*)rp = x4;
      }
      __syncthreads();
    }
  } else {
    u16* es = (u16*)smem;
#pragma unroll
    for (int mi = 0; mi < MI; ++mi)
#pragma unroll
      for (int ni = 0; ni < 2; ++ni)
#pragma unroll
        for (int i = 0; i < 16; ++i) {
          const int lrow = wm * (32 * MI) + mi * 32 + (i & 3) + 8 * (i >> 2) + 4 * hh;
          const int col = n0 + wn * 64 + ni * 32 + r;
          const float v = acc[mi][ni][i];
          es[lrow * 128 + wn * 64 + ni * 32 + r] = f2bf(v);
          if (g.side != nullptr && col >= g.slo && col < g.slo + 32) g.side[(size_t)(m0 + lrow) * 32 + col - g.slo] = v;
        }
    __syncthreads();
#pragma unroll
    for (int j = 0; j < 4 * MI; ++j) {
      const int lrow = (tid >> 4) + 16 * j, ch = tid & 15;
      const int col = n0 + ch * 8;
      if (col < g.nreal) *(u32x4*)(g.o16 + (size_t)(m0 + lrow) * g.ldo + col) = *(const u32x4*)(es + lrow * 128 + ch * 8);
    }
    __syncthreads();
  }
}

template <int EPI, int MI>
DI void gemm_phase(const GemmDesc& g, char* smem, int vb, int nvb) {
  const bool xm = (nvb & 7) == 0 && (g.nM & 7) == 0;
  const int xcd = vb & 7;
  const int mPer = xm ? (g.nM >> 3) : g.nM;
  const int PM = (mPer % 9 == 0) ? 9 : ((mPer & 7) == 0 ? 8 : ((mPer % 6) == 0 ? 6 : mPer));
  const int per = PM * g.nN;
  const int local = mPer * g.nN;
  const int start = xm ? (vb >> 3) : vb, step = xm ? (nvb >> 3) : nvb;
  const int mbase = xm ? xcd * mPer : 0;
  for (int q = start; q < local; q += step) {
    const int mg = q / per;
    const int rem = q - mg * per;
    const int tn = rem / PM;
    const int tm = mbase + mg * PM + (rem - tn * PM);
    gemm_tile<EPI, MI>(g, tm, tn, smem);
  }
}
template <int EPI>
DI void gemm_auto(GemmDesc& g, int M, char* smem, int vb, int nvb) {
  if (M == T) { g.nM = T / 192; gemm_phase<EPI, 3>(g, smem, vb, nvb); }
  else if (M == LAT) { g.nM = 86; gemm_phase<EPI, 3>(g, smem, vb, nvb); }
  else { g.nM = M / 128; gemm_phase<EPI, 2>(g, smem, vb, nvb); }
}

DI GemmDesc gemm_simple(const u16* A, int lda, const u16* Bt, int K, int M, int Npad) {
  GemmDesc g;
  g.A0 = A; g.lda0 = lda; g.kstep0 = 64; g.ksplit = 1 << 20; g.A1 = A; g.lda1 = lda;
  g.Bt = Bt; g.K = K; g.nM = M / 128; g.nN = Npad / 128;
  g.o16 = nullptr; g.ldo = 0; g.nreal = 0; g.side = nullptr; g.slo = 0;
  g.xres = nullptr; g.hres = nullptr; g.mod = nullptr; g.gidx = 0; g.coef = 0.f;
  return g;
}

DI void mla_finalize(const P& p, char* smem, int vb, int nvb) {
  const int tid_ = get_tid();
  const int lane = tid_ & 63, wave = tid_ >> 6;
  const u16* z = (const u16*)(p.ws + OFF_REGB);
  u16* Q = (u16*)(p.ws + OFF_QB);
  u16* Kb = (u16*)(p.ws + OFF_KB);
  u16* KV = (u16*)(p.ws + OFF_REGA);
  float* sq = (float*)smem + wave * 1824;
  float* skv = sq + 768;
  float* skr = skv + 1024;
  const int h = lane >> 3, sub = lane & 7;
  const float QSCALE = 0.10206207261596575f * LOG2E;
  float qn[12], kn[12];
#pragma unroll
  for (int j = 0; j < 12; ++j) { qn[j] = p.ev_q_norm[sub + 8 * j]; kn[j] = p.ev_k_norm[sub + 8 * j]; }
  for (int t = vb * 4 + wave; t < T; t += nvb * 4) {
    float f[8];
    {
      uint4 v = *(const uint4*)(Q + (size_t)t * 768 + lane * 8);
      unpack8(v, f);
#pragma unroll
      for (int j = 0; j < 8; ++j) sq[lane * 8 + j] = f[j];
      if (lane < 32) {
        v = *(const uint4*)(Q + (size_t)t * 768 + (lane + 64) * 8);
        unpack8(v, f);
#pragma unroll
        for (int j = 0; j < 8; ++j) sq[(lane + 64) * 8 + j] = f[j];
      }
    }
    uint4 kv0 = *(const uint4*)(KV + (size_t)t * 1024 + lane * 8);
    uint4 kv1 = *(const uint4*)(KV + (size_t)t * 1024 + (lane + 64) * 8);
    unpack8(kv0, f);
#pragma unroll
    for (int j = 0; j < 8; ++j) skv[lane * 8 + j] = f[j];
    unpack8(kv1, f);
#pragma unroll
    for (int j = 0; j < 8; ++j) skv[(lane + 64) * 8 + j] = f[j];
    if (lane < 32) skr[lane] = bf2f(z[(size_t)t * EVEN_IN + 640 + lane]);
    float ssq = 0.f, sskv = 0.f;
    if (lane < 48) {
      uint4 v = *(const uint4*)(z + (size_t)t * EVEN_IN + lane * 8);
      unpack8(v, f);
#pragma unroll
      for (int j = 0; j < 8; ++j) ssq += f[j] * f[j];
    }
    if (lane < 32) {
      uint4 v = *(const uint4*)(z + (size_t)t * EVEN_IN + 384 + lane * 8);
      unpack8(v, f);
#pragma unroll
      for (int j = 0; j < 8; ++j) sskv += f[j] * f[j];
    }
    ssq = wave_sum(ssq);
    sskv = wave_sum(sskv);
    const float rq = rsqrtf(ssq * (1.f / 384.f) + EPS), rkv = rsqrtf(sskv * (1.f / 256.f) + EPS);
    const bool lat = t < LAT;
    const int pos = t & 2047;
    float cs = 1.f, sn = 0.f;
    if (lat) {
      const int fi = lane & 7;
      const float inv = exp2f(-(float)fi * (13.287712379549449f / 8.f));
      const float pc = (lane & 8) ? (float)(pos & 63) : (float)(pos >> 6);
      float rev = pc * inv * 0.15915494309189535f;
      rev -= floorf(rev);
      cs = __builtin_amdgcn_cosf(rev);
      sn = __builtin_amdgcn_sinf(rev);
    }
    const float c0 = __shfl(cs, sub), s0 = __shfl(sn, sub), c1 = __shfl(cs, sub + 8), s1 = __shfl(sn, sub + 8);
    wave_lds_sync();
    float y[12];
    float ss = 0.f;
#pragma unroll
    for (int j = 0; j < 12; ++j) { y[j] = sq[h * 96 + sub + 8 * j] * rq; ss += y[j] * y[j]; }
    ss += __shfl_xor(ss, 1); ss += __shfl_xor(ss, 2); ss += __shfl_xor(ss, 4);
    float rms = rsqrtf(ss * (1.f / 96.f) + EPS);
#pragma unroll
    for (int j = 0; j < 12; ++j) y[j] *= rms * qn[j];
    if (lat) {
      const float a8 = y[8] * c0 - y[10] * s0, a10 = y[8] * s0 + y[10] * c0;
      const float a9 = y[9] * c1 - y[11] * s1, a11 = y[9] * s1 + y[11] * c1;
      y[8] = a8; y[10] = a10; y[9] = a9; y[11] = a11;
    }
    float kk[12];
    float ssk = 0.f;
#pragma unroll
    for (int j = 0; j < 12; ++j) {
      kk[j] = j < 8 ? skv[h * 128 + sub + 8 * j] * rkv : skr[sub + 8 * j - 64];
      ssk += kk[j] * kk[j];
    }
    ssk += __shfl_xor(ssk, 1); ssk += __shfl_xor(ssk, 2); ssk += __shfl_xor(ssk, 4);
    rms = rsqrtf(ssk * (1.f / 96.f) + EPS);
#pragma unroll
    for (int j = 0; j < 12; ++j) kk[j] *= rms * kn[j];
    if (lat) {
      const float a8 = kk[8] * c0 - kk[10] * s0, a10 = kk[8] * s0 + kk[10] * c0;
      const float a9 = kk[9] * c1 - kk[11] * s1, a11 = kk[9] * s1 + kk[11] * c1;
      kk[8] = a8; kk[10] = a10; kk[9] = a9; kk[11] = a11;
    }
    wave_lds_sync();
#pragma unroll
    for (int j = 0; j < 12; ++j) sq[h * 96 + sub + 8 * j] = y[j] * QSCALE;
    wave_lds_sync();
    {
      *(uint4*)(Q + (size_t)t * 768 + lane * 8) = pack8(sq + lane * 8);
      if (lane < 32) *(uint4*)(Q + (size_t)t * 768 + (lane + 64) * 8) = pack8(sq + (lane + 64) * 8);
    }
    wave_lds_sync();
#pragma unroll
    for (int j = 0; j < 12; ++j) sq[h * 96 + sub + 8 * j] = kk[j];
    wave_lds_sync();
    {
      *(uint4*)(Kb + (size_t)t * 768 + lane * 8) = pack8(sq + lane * 8);
      if (lane < 32) *(uint4*)(Kb + (size_t)t * 768 + (lane + 64) * 8) = pack8(sq + (lane + 64) * 8);
    }
    if (lane & 8) {
      unpack8(kv0, f);
#pragma unroll
      for (int j = 0; j < 8; ++j) f[j] *= rkv;
      *(uint4*)(KV + (size_t)t * 1024 + lane * 8) = pack8(f);
      unpack8(kv1, f);
#pragma unroll
      for (int j = 0; j < 8; ++j) f[j] *= rkv;
      *(uint4*)(KV + (size_t)t * 1024 + (lane + 64) * 8) = pack8(f);
    }
    wave_lds_sync();
  }
}

DI void swa_finalize(const P& p, char* smem, int vb, int nvb) {
  const int tid_ = get_tid();
  const int lane = tid_ & 63, wave = tid_ >> 6;
  const u16* z = (const u16*)(p.ws + OFF_REGB);
  u16* Q = (u16*)(p.ws + OFF_QB);
  u16* Kb = (u16*)(p.ws + OFF_KB);
  const int sub = lane & 7;
  const float SSCALE = 0.125f * LOG2E;
  float qn[8], kn[8];
#pragma unroll
  for (int j = 0; j < 8; ++j) { qn[j] = p.od_q_norm[sub * 8 + j]; kn[j] = p.od_k_norm[sub * 8 + j]; }
  const float* side = (const float*)(p.ws + OFF_SIDE);
  float* alpha0 = (float*)(p.ws + OFF_KB + (size_t)T * 128 * 2);
  float* alpha1 = (float*)(p.ws + OFF_REGA + (size_t)LAT * 512 * 2);
  float* w2s = (float*)smem;
  float* gbs = w2s + 8192;
  float* sds = gbs + 512 + wave * 32;
  __syncthreads();
  for (int i = tid_; i < 8192; i += NTHR) w2s[i] = p.od_w2[i];
  for (int i = tid_; i < 512; i += NTHR) gbs[i] = p.od_gb[i];
  __syncthreads();
  for (int t = vb * 4 + wave; t < T; t += nvb * 4) {
    if (lane < 32) sds[lane] = side[(size_t)t * 32 + lane];
    wave_lds_sync();
#pragma unroll
    for (int dr = 0; dr < 2; ++dr) {
      f32x4v lg = *(const f32x4v*)(gbs + dr * 256 + lane * 4);
#pragma unroll
      for (int r4 = 0; r4 < 4; ++r4) {
        const f32x4v zg = *(const f32x4v*)(sds + dr * 16 + r4 * 4);
        lg += *(const f32x4v*)(w2s + (dr * 16 + r4 * 4 + 0) * 256 + lane * 4) * zg.x;
        lg += *(const f32x4v*)(w2s + (dr * 16 + r4 * 4 + 1) * 256 + lane * 4) * zg.y;
        lg += *(const f32x4v*)(w2s + (dr * 16 + r4 * 4 + 2) * 256 + lane * 4) * zg.z;
        lg += *(const f32x4v*)(w2s + (dr * 16 + r4 * 4 + 3) * 256 + lane * 4) * zg.w;
      }
      f32x4v al;
      al.x = __expf((fminf(lg.x, 0.f) - __logf(1.f + __expf(-fabsf(lg.x)))) * (1.f / 16.f));
      al.y = __expf((fminf(lg.y, 0.f) - __logf(1.f + __expf(-fabsf(lg.y)))) * (1.f / 16.f));
      al.z = __expf((fminf(lg.z, 0.f) - __logf(1.f + __expf(-fabsf(lg.z)))) * (1.f / 16.f));
      al.w = __expf((fminf(lg.w, 0.f) - __logf(1.f + __expf(-fabsf(lg.w)))) * (1.f / 16.f));
      *(f32x4v*)((dr == 0 ? alpha0 : alpha1) + (size_t)t * 256 + lane * 4) = al;
    }
    wave_lds_sync();
    const bool lat = t < LAT;
    const int pos = t & 2047;
    float cs = 1.f, sn = 0.f;
    if (lat) {
      const int fi = lane & 15;
      const float inv = exp2f(-(float)fi * (13.287712379549449f / 16.f));
      const float pc = (lane & 16) ? (float)(pos & 63) : (float)(pos >> 6);
      float rev = pc * inv * 0.15915494309189535f;
      rev -= floorf(rev);
      cs = __builtin_amdgcn_cosf(rev);
      sn = __builtin_amdgcn_sinf(rev);
    }
    float cj[8], sj[8];
#pragma unroll
    for (int j = 0; j < 8; ++j) { cj[j] = __shfl(cs, (sub & 3) * 8 + j); sj[j] = __shfl(sn, (sub & 3) * 8 + j); }
    float f[8];
    if (lat) {
      uint4 v = *(const uint4*)(z + (size_t)t * ODD_IN + 1568 + lane * 8);
      unpack8(v, f);
      float ss = 0.f;
#pragma unroll
      for (int j = 0; j < 8; ++j) ss += f[j] * f[j];
      ss += __shfl_xor(ss, 1); ss += __shfl_xor(ss, 2); ss += __shfl_xor(ss, 4);
      const float rms = rsqrtf(ss * (1.f / 64.f) + EPS);
#pragma unroll
      for (int j = 0; j < 8; ++j) {
        const float yv = f[j] * rms * qn[j];
        const float pv = __shfl_xor(yv, 4);
        const float o = (sub < 4) ? (yv * cj[j] - pv * sj[j]) : (pv * sj[j] + yv * cj[j]);
        f[j] = o * SSCALE;
      }
      *(uint4*)(Q + (size_t)t * 512 + lane * 8) = pack8(f);
    }
    {
      const int l16 = lane & 15;
      uint4 v = *(const uint4*)(z + (size_t)t * ODD_IN + 2080 + l16 * 8);
      unpack8(v, f);
      float ss = 0.f;
#pragma unroll
      for (int j = 0; j < 8; ++j) ss += f[j] * f[j];
      ss += __shfl_xor(ss, 1); ss += __shfl_xor(ss, 2); ss += __shfl_xor(ss, 4);
      const float rms = rsqrtf(ss * (1.f / 64.f) + EPS);
#pragma unroll
      for (int j = 0; j < 8; ++j) {
        const float yv = f[j] * rms * kn[j];
        const float pv = __shfl_xor(yv, 4);
        float o = yv;
        if (lat) o = (sub < 4) ? (yv * cj[j] - pv * sj[j]) : (pv * sj[j] + yv * cj[j]);
        f[j] = o;
      }
      if (lane < 16) *(uint4*)(Kb + (size_t)t * 128 + lane * 8) = pack8(f);
    }
  }
}

template <int DQK, bool SWA>
DI void attn_item(const u16* __restrict__ Q, int ldq, int qoff, const u16* __restrict__ Kp, int ldk, int koff,
                  const u16* __restrict__ Vp, int ldv, int voff, int qrow0, int qpos0, int crow0, int lrow0, int kt_lo,
                  int kt_hi, float sink2, u16* __restrict__ O, int ldo, int ooff, char* smem) {
  constexpr int KSTR = DQK + 8, VSTR = 72, CPR = DQK / 8, NKC = 64 * CPR / 256, NKS = DQK / 16;
  u16* Ks = (u16*)smem;
  u16* Vt = Ks + 2 * 64 * KSTR;
  const int tid = get_tid(), lane = tid & 63, wave = tid >> 6, r = lane & 31, hh = lane >> 5;
  const int nt = 4 + (kt_hi - kt_lo);
  bf16x8 bq[NKS];
  {
    const u16* qp = Q + (size_t)(qrow0 + wave * 32 + r) * ldq + qoff + hh * 8;
#pragma unroll
    for (int ks = 0; ks < NKS; ++ks) bq[ks] = *(const bf16x8*)(qp + ks * 16);
  }
  u32x4 rk[NKC], rv[2];
#define A_LOADG(IT)                                                                                   \
  {                                                                                                   \
    const int i_ = (IT);                                                                              \
    const int base_ = i_ < 4 ? crow0 + i_ * 64 : lrow0 + (kt_lo + i_ - 4) * 64;                       \
    _Pragma("unroll") for (int j = 0; j < NKC; ++j) {                                                 \
      const int c = tid + 256 * j, row = c / CPR, kc = c % CPR;                                       \
      rk[j] = *(const u32x4*)(Kp + (size_t)(base_ + row) * ldk + koff + kc * 8);                      \
    }                                                                                                 \
    _Pragma("unroll") for (int j = 0; j < 2; ++j) {                                                   \
      const int c = tid + 256 * j, row = c >> 3, dc = c & 7;                                          \
      rv[j] = *(const u32x4*)(Vp + (size_t)(base_ + row) * ldv + voff + dc * 8);                      \
    }                                                                                                 \
  }
#define A_STORES(BUF)                                                                                 \
  {                                                                                                   \
    const int buf_ = (BUF);                                                                           \
    _Pragma("unroll") for (int j = 0; j < NKC; ++j) {                                                 \
      const int c = tid + 256 * j, row = c / CPR, kc = c % CPR;                                       \
      *(u32x4*)(Ks + buf_ * 64 * KSTR + row * KSTR + kc * 8) = rk[j];                                 \
    }                                                                                                 \
    _Pragma("unroll") for (int j = 0; j < 2; ++j) {                                                   \
      const int c = tid + 256 * j, key = c >> 3, dc = c & 7;                                          \
      u16* vb = Vt + buf_ * 64 * VSTR + (dc * 8) * VSTR + key;                                        \
      const unsigned w0 = rv[j].x, w1 = rv[j].y, w2 = rv[j].z, w3 = rv[j].w;                          \
      vb[0 * VSTR] = (u16)(w0 & 0xffff); vb[1 * VSTR] = (u16)(w0 >> 16);                              \
      vb[2 * VSTR] = (u16)(w1 & 0xffff); vb[3 * VSTR] = (u16)(w1 >> 16);                              \
      vb[4 * VSTR] = (u16)(w2 & 0xffff); vb[5 * VSTR] = (u16)(w2 >> 16);                              \
      vb[6 * VSTR] = (u16)(w3 & 0xffff); vb[7 * VSTR] = (u16)(w3 >> 16);                              \
    }                                                                                                 \
  }
  f32x16 o[2];
#pragma unroll
  for (int a = 0; a < 2; ++a)
#pragma unroll
    for (int i = 0; i < 16; ++i) o[a][i] = 0.f;
  float m = -INFINITY, lsum = 0.f;
  A_LOADG(0);
  A_STORES(0);
  __syncthreads();
  for (int it = 0; it < nt; ++it) {
    const int buf = it & 1;
    if (it + 1 < nt) A_LOADG(it + 1);
    f32x16 s[2];
#pragma unroll
    for (int mt = 0; mt < 2; ++mt) {
#pragma unroll
      for (int i = 0; i < 16; ++i) s[mt][i] = 0.f;
      const u16* kb = Ks + buf * 64 * KSTR + (mt * 32 + r) * KSTR + hh * 8;
#pragma unroll
      for (int ks = 0; ks < NKS; ++ks) {
        const bf16x8 a = *(const bf16x8*)(kb + ks * 16);
        s[mt] = MFMA(a, bq[ks], s[mt]);
      }
    }
    if (SWA && it >= 4) {
      const int kpos0 = (kt_lo + it - 4) * 64;
      const int qpos = qpos0 + wave * 32 + r;
#pragma unroll
      for (int mt = 0; mt < 2; ++mt)
#pragma unroll
        for (int i = 0; i < 16; ++i) {
          const int kpos = kpos0 + mt * 32 + (i & 3) + 8 * (i >> 2) + 4 * hh;
          const int dlt = kpos - qpos;
          if (dlt > 128 || dlt < -128) s[mt][i] = -INFINITY;
        }
    }
    float mx = -INFINITY;
#pragma unroll
    for (int mt = 0; mt < 2; ++mt)
#pragma unroll
      for (int i = 0; i < 16; ++i) mx = fmaxf(mx, s[mt][i]);
    mx = fmaxf(mx, __shfl_xor(mx, 32));
    const float mnew = fmaxf(m, mx);
    const bool chg = __ballot(mnew > m) != 0ull;
    const float alpha = chg ? __builtin_amdgcn_exp2f(m - mnew) : 1.f;
    m = mnew;
    float psum = 0.f;
#pragma unroll
    for (int mt = 0; mt < 2; ++mt)
#pragma unroll
      for (int i = 0; i < 16; ++i) {
        const float pv = __builtin_amdgcn_exp2f(s[mt][i] - mnew);
        s[mt][i] = pv;
        psum += pv;
      }
    if (chg) {
      lsum *= alpha;
#pragma unroll
      for (int a = 0; a < 2; ++a)
#pragma unroll
        for (int i = 0; i < 16; ++i) o[a][i] *= alpha;
    }
    lsum += psum;
#pragma unroll
    for (int mt = 0; mt < 2; ++mt)
#pragma unroll
      for (int sx = 0; sx < 2; ++sx) {
        uint4 pu;
        pu.x = pack2(s[mt][8 * sx + 0], s[mt][8 * sx + 1]);
        pu.y = pack2(s[mt][8 * sx + 2], s[mt][8 * sx + 3]);
        pu.z = pack2(s[mt][8 * sx + 4], s[mt][8 * sx + 5]);
        pu.w = pack2(s[mt][8 * sx + 6], s[mt][8 * sx + 7]);
        const bf16x8 pfv = __builtin_bit_cast(bf16x8, pu);
#pragma unroll
        for (int dt = 0; dt < 2; ++dt) {
          const u16* vp = Vt + buf * 64 * VSTR + (dt * 32 + r) * VSTR + mt * 32 + 16 * sx + 4 * hh;
          const uint2 v0 = *(const uint2*)(vp);
          const uint2 v1 = *(const uint2*)(vp + 8);
          const uint4 vu = make_uint4(v0.x, v0.y, v1.x, v1.y);
          o[dt] = MFMA(__builtin_bit_cast(bf16x8, vu), pfv, o[dt]);
        }
      }
    if (it + 1 < nt) A_STORES(buf ^ 1);
    __syncthreads();
  }
  float l = lsum + __shfl_xor(lsum, 32);
  if (SWA) l += __builtin_amdgcn_exp2f(sink2 - m);
  const float inv = 1.f / l;
  u16* op = O + (size_t)(qrow0 + wave * 32 + r) * ldo + ooff;
#pragma unroll
  for (int dt = 0; dt < 2; ++dt)
#pragma unroll
    for (int g4 = 0; g4 < 4; ++g4) {
      uint2 w;
      w.x = pack2(o[dt][4 * g4 + 0] * inv, o[dt][4 * g4 + 1] * inv);
      w.y = pack2(o[dt][4 * g4 + 2] * inv, o[dt][4 * g4 + 3] * inv);
      *(uint2*)(op + dt * 32 + 8 * g4 + 4 * hh) = w;
    }
}

DI void gdn_chain(const P& p, int cid, char* smem) {
  const int eb = cid & 1, chn = cid >> 1;
  const int dir = chn >> 6, b = (chn >> 3) & 7, h = chn & 7;
  float* qs = (float*)smem;
  float* ks = qs + 4096;
  float* vs = ks + 4096;
  float* ob = vs + 2048;
  float* ps = ob + 2048;
  float* cw = ps + 256;
  const int tid = get_tid(), lane = tid & 63, wave = tid >> 6;
  const u16* z = (const u16*)(p.ws + OFF_REGB);
  const float* side = (const float*)(p.ws + OFF_SIDE);
  u16* od = (u16*)(p.ws + OFF_ODIR) + (size_t)dir * T * 512;
  __syncthreads();
  for (int i = tid; i < 800; i += NTHR) {
    const int j = i / 160, cc = i % 160;
    const int chi = cc < 64 ? h * 64 + cc : (cc < 128 ? 512 + h * 64 + (cc - 64) : 1024 + h * 64 + eb * 32 + (cc - 128));
    cw[i] = p.ev_conv[j * 1536 + chi];
  }
  const float Aexp = __expf(p.ev_a_log[dir * 8 + h]);
  const float dtb = p.ev_dt_bias[dir * 8 + h];
  __builtin_amdgcn_s_setprio(3);
  f32x2 S[4];
#pragma unroll
  for (int i = 0; i < 4; ++i) S[i] = (f32x2){0.f, 0.f};
  const int dl = lane & 7, ec = wave * 8 + (lane >> 3);
  const int pp = tid >> 2, qd = tid & 3;
  __syncthreads();
  for (int seg = 0; seg < 2; ++seg) {
    const int len = seg == 0 ? CTXL : SEQ;
    const int base = seg == 0 ? LAT + b * CTXL : b * SEQ;
    for (int c = 0; c < len / 64; ++c) {
      {
        const int pos = c * 64 + pp;
        const int tau = dir ? len - 1 - pos : pos;
        float aq[16], ak[16], av[8];
#pragma unroll
        for (int i = 0; i < 16; ++i) { aq[i] = 0.f; ak[i] = 0.f; }
#pragma unroll
        for (int i = 0; i < 8; ++i) av[i] = 0.f;
#pragma unroll
        for (int j = 0; j < 5; ++j) {
          const int tt = tau + j - 2;
          if (tt >= 0 && tt < len) {
            const u16* zr = z + (size_t)(base + tt) * EVEN_IN + h * 64;
            float f[16];
            unpack8(*(const uint4*)(zr + 672 + qd * 16), f); unpack8(*(const uint4*)(zr + 672 + qd * 16 + 8), f + 8);
#pragma unroll
            for (int i = 0; i < 16; ++i) aq[i] += cw[j * 160 + qd * 16 + i] * f[i];
            unpack8(*(const uint4*)(zr + 1184 + qd * 16), f); unpack8(*(const uint4*)(zr + 1184 + qd * 16 + 8), f + 8);
#pragma unroll
            for (int i = 0; i < 16; ++i) ak[i] += cw[j * 160 + 64 + qd * 16 + i] * f[i];
            unpack8(*(const uint4*)(zr + 1696 + eb * 32 + qd * 8), f);
#pragma unroll
            for (int i = 0; i < 8; ++i) av[i] += cw[j * 160 + 128 + qd * 8 + i] * f[i];
          }
        }
        float sq2 = 0.f, sk2 = 0.f;
#pragma unroll
        for (int i = 0; i < 16; ++i) {
          aq[i] = silu_f(aq[i]); ak[i] = silu_f(ak[i]);
          sq2 += aq[i] * aq[i]; sk2 += ak[i] * ak[i];
        }
        sq2 = quad_sum(sq2);
        sk2 = quad_sum(sk2);
        const float rq = rsqrtf(sq2 + EPS) * 0.125f, rk = rsqrtf(sk2 + EPS);
#pragma unroll
        for (int i = 0; i < 16; ++i) { aq[i] *= rq; ak[i] *= rk; }
#pragma unroll
        for (int i = 0; i < 4; ++i) {
          *(float4*)(qs + pp * 64 + qd * 16 + i * 4) = make_float4(aq[4 * i], aq[4 * i + 1], aq[4 * i + 2], aq[4 * i + 3]);
          *(float4*)(ks + pp * 64 + qd * 16 + i * 4) = make_float4(ak[4 * i], ak[4 * i + 1], ak[4 * i + 2], ak[4 * i + 3]);
        }
        *(float4*)(vs + pp * 32 + qd * 8) = make_float4(silu_f(av[0]), silu_f(av[1]), silu_f(av[2]), silu_f(av[3]));
        *(float4*)(vs + pp * 32 + qd * 8 + 4) = make_float4(silu_f(av[4]), silu_f(av[5]), silu_f(av[6]), silu_f(av[7]));
        float gsame = 0.f, kk = 0.f, g21 = 0.f;
#pragma unroll
        for (int i = 0; i < 16; ++i) {
          const float kp = __builtin_bit_cast(float, __builtin_amdgcn_mov_dpp(__builtin_bit_cast(int, ak[i]), 0x114, 0xF, 0xF, true));
          gsame += aq[i] * ak[i];
          kk += kp * ak[i];
          g21 += aq[i] * kp;
        }
        gsame = quad_sum(gsame);
        kk = quad_sum(kk);
        g21 = quad_sum(g21);
        if (qd == 0) {
          const float za = side[(size_t)(base + tau) * 32 + dir * 8 + h];
          const float zb = side[(size_t)(base + tau) * 32 + 16 + dir * 8 + h];
          const float av_ = __expf(-Aexp * softplus_f(za + dtb));
          const float bv_ = sigmoid_f(zb);
          float* pr = ps + (pp >> 1) * 8;
          if (pp & 1) { pr[2] = av_; pr[3] = bv_; pr[4] = kk; pr[6] = g21; pr[7] = gsame; }
          else { pr[0] = av_; pr[1] = bv_; pr[5] = gsame; }
        }
      }
      __syncthreads();
#define GDN_LOAD2(M, X)                                                                     \
  X##k1a = *(const f32x4v*)(ks + (2 * (M)) * 64 + dl * 8); X##k1b = *(const f32x4v*)(ks + (2 * (M)) * 64 + dl * 8 + 4);         \
  X##k2a = *(const f32x4v*)(ks + (2 * (M) + 1) * 64 + dl * 8); X##k2b = *(const f32x4v*)(ks + (2 * (M) + 1) * 64 + dl * 8 + 4); \
  X##q1a = *(const f32x4v*)(qs + (2 * (M)) * 64 + dl * 8); X##q1b = *(const f32x4v*)(qs + (2 * (M)) * 64 + dl * 8 + 4);         \
  X##q2a = *(const f32x4v*)(qs + (2 * (M) + 1) * 64 + dl * 8); X##q2b = *(const f32x4v*)(qs + (2 * (M) + 1) * 64 + dl * 8 + 4); \
  X##v1 = vs[(2 * (M)) * 32 + ec]; X##v2 = vs[(2 * (M) + 1) * 32 + ec];                      \
  X##s0 = *(const f32x4v*)(ps + (M) * 8); X##s1 = *(const f32x4v*)(ps + (M) * 8 + 4);        \
  __builtin_amdgcn_sched_barrier(0);
#define GDN_DOT(VA, VB, OUT)                                                                \
  {                                                                                         \
    f32x2 d_ = VA.xy * S[0] + VA.zw * S[1];                                                 \
    d_ += VB.xy * S[2] + VB.zw * S[3];                                                      \
    OUT = d_.x + d_.y;                                                                      \
  }
#define GDN_STEP2(U, X)                                                                     \
  {                                                                                         \
    const float a1 = X##s0.x, b1 = X##s0.y, a2 = X##s0.z, b2 = X##s0.w;                     \
    const float kk = X##s1.x, g11 = X##s1.y, g21 = X##s1.z, g22 = X##s1.w;                  \
    float p1, p2, r1, r2;                                                                   \
    GDN_DOT(X##k1a, X##k1b, p1) GDN_DOT(X##k2a, X##k2b, p2)                                 \
    GDN_DOT(X##q1a, X##q1b, r1) GDN_DOT(X##q2a, X##q2b, r2)                                 \
    p1 = row8_sum(p1); p2 = row8_sum(p2); r1 = row8_sum(r1); r2 = row8_sum(r2);             \
    const float c1 = b1 * (X##v1 - a1 * p1);                                                \
    const float o1 = a1 * r1 + g11 * c1;                                                    \
    const float c2 = b2 * (X##v2 - a2 * (a1 * p2 + kk * c1));                               \
    const float o2 = a2 * (a1 * r2 + g21 * c1) + g22 * c2;                                  \
    const float a21 = a2 * a1, w1 = a2 * c1;                                                \
    const f32x2 A2 = (f32x2){a21, a21}, W1 = (f32x2){w1, w1}, C2 = (f32x2){c2, c2};          \
    S[0] = A2 * S[0] + X##k1a.xy * W1 + X##k2a.xy * C2;                                     \
    S[1] = A2 * S[1] + X##k1a.zw * W1 + X##k2a.zw * C2;                                     \
    S[2] = A2 * S[2] + X##k1b.xy * W1 + X##k2b.xy * C2;                                     \
    S[3] = A2 * S[3] + X##k1b.zw * W1 + X##k2b.zw * C2;                                     \
    myo = (dl == 2 * (U)) ? o1 : myo;                                                       \
    myo = (dl == 2 * (U) + 1) ? o2 : myo;                                                   \
    __builtin_amdgcn_sched_barrier(0);                                                      \
  }
      f32x4v Ak1a, Ak1b, Ak2a, Ak2b, Aq1a, Aq1b, Aq2a, Aq2b, As0, As1;
      f32x4v Bk1a, Bk1b, Bk2a, Bk2b, Bq1a, Bq1b, Bq2a, Bq2b, Bs0, Bs1;
      float Av1, Av2, Bv1, Bv2;
      GDN_LOAD2(0, A)
      for (int t0 = 0; t0 < 64; t0 += 8) {
        float myo = 0.f;
        const int m0 = t0 >> 1;
        GDN_LOAD2(m0 + 1, B) GDN_STEP2(0, A)
        GDN_LOAD2(m0 + 2, A) GDN_STEP2(1, B)
        GDN_LOAD2(m0 + 3, B) GDN_STEP2(2, A)
        GDN_LOAD2(m0 + 4, A) GDN_STEP2(3, B)
        const int pos = c * 64 + t0 + dl;
        const int tau = dir ? len - 1 - pos : pos;
        od[(size_t)(base + tau) * 512 + h * 64 + eb * 32 + ec] = f2bf(myo);
      }
      __syncthreads();
    }
  }
  __builtin_amdgcn_s_setprio(0);
}

DI void gla_chain(const P& p, int cid, char* smem) {
  const int e4 = cid & 3, chn = cid >> 2;
  const int dir = chn >> 5, b = (chn >> 2) & 7, h = chn & 3;
  float* qs = (float*)smem;
  float* ks = qs + 4096;
  float* as = ks + 4096;
  float* vs = as + 4096;
  float* ob = vs + 2048;
  const int tid = get_tid(), lane = tid & 63, wave = tid >> 6;
  const u16* z = (const u16*)(p.ws + OFF_REGB);
  const float* alpha = dir == 0 ? (const float*)(p.ws + OFF_KB + (size_t)T * 128 * 2)
                                : (const float*)(p.ws + OFF_REGA + (size_t)LAT * 512 * 2);
  u16* od = (u16*)(p.ws + OFF_ODIR) + (size_t)dir * T * 512;
  __builtin_amdgcn_s_setprio(3);
  f32x2 S[4];
#pragma unroll
  for (int i = 0; i < 4; ++i) S[i] = (f32x2){0.f, 0.f};
  const int dl = lane & 7, ec = wave * 8 + (lane >> 3);
  const int pp = tid >> 2, qd = tid & 3;
  __syncthreads();
  for (int seg = 0; seg < 2; ++seg) {
    const int len = seg == 0 ? CTXL : SEQ;
    const int base = seg == 0 ? LAT + b * CTXL : b * SEQ;
    for (int c = 0; c < len / 64; ++c) {
      {
        const int pos = c * 64 + pp;
        const int tau = dir ? len - 1 - pos : pos;
        const u16* zr = z + (size_t)(base + tau) * ODD_IN;
        float f[16];
        unpack8(*(const uint4*)(zr + h * 64 + qd * 16), f); unpack8(*(const uint4*)(zr + h * 64 + qd * 16 + 8), f + 8);
#pragma unroll
        for (int i = 0; i < 4; ++i)
          *(float4*)(qs + pp * 64 + qd * 16 + i * 4) =
              make_float4(f[4 * i] * 0.125f, f[4 * i + 1] * 0.125f, f[4 * i + 2] * 0.125f, f[4 * i + 3] * 0.125f);
        unpack8(*(const uint4*)(zr + 256 + h * 64 + qd * 16), f); unpack8(*(const uint4*)(zr + 256 + h * 64 + qd * 16 + 8), f + 8);
#pragma unroll
        for (int i = 0; i < 4; ++i)
          *(float4*)(ks + pp * 64 + qd * 16 + i * 4) = make_float4(f[4 * i], f[4 * i + 1], f[4 * i + 2], f[4 * i + 3]);
        const float* ar = alpha + (size_t)(base + tau) * 256 + h * 64 + qd * 16;
#pragma unroll
        for (int i = 0; i < 4; ++i) *(float4*)(as + pp * 64 + qd * 16 + i * 4) = *(const float4*)(ar + i * 4);
        unpack8(*(const uint4*)(zr + 512 + h * 128 + e4 * 32 + qd * 8), f);
        *(float4*)(vs + pp * 32 + qd * 8) = make_float4(f[0], f[1], f[2], f[3]);
        *(float4*)(vs + pp * 32 + qd * 8 + 4) = make_float4(f[4], f[5], f[6], f[7]);
      }
      __syncthreads();
      if (seg == 0) {
#pragma unroll 4
        for (int t = 0; t < 64; ++t) {
          const f32x4v ka = *(const f32x4v*)(ks + t * 64 + dl * 8), kb = *(const f32x4v*)(ks + t * 64 + dl * 8 + 4);
          const f32x4v aa = *(const f32x4v*)(as + t * 64 + dl * 8), ab = *(const f32x4v*)(as + t * 64 + dl * 8 + 4);
          const float v = vs[t * 32 + ec];
          const f32x2 v2 = (f32x2){v, v};
          S[0] = aa.xy * S[0] + ka.xy * v2; S[1] = aa.zw * S[1] + ka.zw * v2;
          S[2] = ab.xy * S[2] + kb.xy * v2; S[3] = ab.zw * S[3] + kb.zw * v2;
        }
        __syncthreads();
      } else {
#define GLA_LOAD(TT, X)                                                                     \
  X##ka = *(const f32x4v*)(ks + (TT) * 64 + dl * 8); X##kb = *(const f32x4v*)(ks + (TT) * 64 + dl * 8 + 4); \
  X##qa = *(const f32x4v*)(qs + (TT) * 64 + dl * 8); X##qb = *(const f32x4v*)(qs + (TT) * 64 + dl * 8 + 4); \
  X##aa = *(const f32x4v*)(as + (TT) * 64 + dl * 8); X##ab = *(const f32x4v*)(as + (TT) * 64 + dl * 8 + 4); \
  X##v = vs[(TT) * 32 + ec];                                                                \
  __builtin_amdgcn_sched_barrier(0);
#define GLA_STEP(U, X)                                                                      \
  {                                                                                         \
    const f32x2 v2 = (f32x2){X##v, X##v};                                                   \
    S[0] = X##aa.xy * S[0] + X##ka.xy * v2; S[1] = X##aa.zw * S[1] + X##ka.zw * v2;         \
    S[2] = X##ab.xy * S[2] + X##kb.xy * v2; S[3] = X##ab.zw * S[3] + X##kb.zw * v2;         \
    f32x2 orr = X##qa.xy * S[0] + X##qa.zw * S[1];                                          \
    orr += X##qb.xy * S[2] + X##qb.zw * S[3];                                               \
    const float ov = row8_sum(orr.x + orr.y);                                               \
    myo = (dl == (U)) ? ov : myo;                                                           \
    __builtin_amdgcn_sched_barrier(0);                                                      \
  }
        f32x4v Aka, Akb, Aqa, Aqb, Aaa, Aab, Bka, Bkb, Bqa, Bqb, Baa, Bab;
        float Av, Bv;
        GLA_LOAD(0, A)
        for (int t0 = 0; t0 < 64; t0 += 8) {
          float myo = 0.f;
          GLA_LOAD(t0 + 1, B) GLA_STEP(0, A)
          GLA_LOAD(t0 + 2, A) GLA_STEP(1, B)
          GLA_LOAD(t0 + 3, B) GLA_STEP(2, A)
          GLA_LOAD(t0 + 4, A) GLA_STEP(3, B)
          GLA_LOAD(t0 + 5, B) GLA_STEP(4, A)
          GLA_LOAD(t0 + 6, A) GLA_STEP(5, B)
          GLA_LOAD(t0 + 7, B) GLA_STEP(6, A)
          GLA_LOAD(t0 + 8, A) GLA_STEP(7, B)
          const int pos = c * 64 + t0 + dl;
          const int tau = dir ? len - 1 - pos : pos;
          od[(size_t)(base + tau) * 512 + h * 128 + e4 * 32 + ec] = f2bf(myo);
        }
        __syncthreads();
      }
    }
  }
  __builtin_amdgcn_s_setprio(0);
}

DI void gla_chain_mfma(const P& p, int cid, char* smem) {
  const int eh = cid & 1, chn = cid >> 1;
  const int dir = chn >> 5, b = (chn >> 2) & 7, h = chn & 3;
  u16* QD = (u16*)smem;
  u16* KI = QD + 64 * 72;
  u16* KDT = KI + 64 * 72;
  u16* VT = KDT + 64 * 72;
  u16* ST = VT + 64 * 72;
  float* BC = (float*)(ST + 64 * 72);
  const int tid = get_tid(), lane = tid & 63, wave = tid >> 6, r = lane & 31, hh = lane >> 5;
  const int et = wave >> 1, it = wave & 1;
  const int pp = tid >> 2, q4 = tid & 3;
  const u16* z = (const u16*)(p.ws + OFF_REGB);
  const float* alpha = dir == 0 ? (const float*)(p.ws + OFF_KB + (size_t)T * 128 * 2)
                                : (const float*)(p.ws + OFF_REGA + (size_t)LAT * 512 * 2);
  u16* od = (u16*)(p.ws + OFF_ODIR) + (size_t)dir * T * 512;
  __syncthreads();
  for (int i = tid; i < 64 * 72 / 2; i += NTHR) ((unsigned*)ST)[i] = 0u;
  f32x16 Sreg;
#pragma unroll
  for (int i = 0; i < 16; ++i) Sreg[i] = 0.f;
  __syncthreads();
  u32x4 rq0, rq1, rk0, rk1, rv0, rv1;
  f32x4v ra0, ra1, ra2, ra3;
#define GLM_RAW(G)                                                                                    \
  {                                                                                                   \
    const int g_ = (G);                                                                               \
    const int sg_ = g_ < 4 ? 0 : 1, c_ = sg_ ? g_ - 4 : g_;                                           \
    const int len_ = sg_ ? SEQ : CTXL, base_ = sg_ ? b * SEQ : LAT + b * CTXL;                        \
    const int pos_ = c_ * 64 + pp;                                                                    \
    const int tau_ = dir ? len_ - 1 - pos_ : pos_;                                                    \
    const u16* zr_ = z + (size_t)(base_ + tau_) * ODD_IN;                                             \
    rq0 = *(const u32x4*)(zr_ + h * 64 + q4 * 16); rq1 = *(const u32x4*)(zr_ + h * 64 + q4 * 16 + 8); \
    rk0 = *(const u32x4*)(zr_ + 256 + h * 64 + q4 * 16); rk1 = *(const u32x4*)(zr_ + 256 + h * 64 + q4 * 16 + 8); \
    rv0 = *(const u32x4*)(zr_ + 512 + h * 128 + eh * 64 + q4 * 16);                                   \
    rv1 = *(const u32x4*)(zr_ + 512 + h * 128 + eh * 64 + q4 * 16 + 8);                               \
    const float* ar_ = alpha + (size_t)(base_ + tau_) * 256 + h * 64 + q4 * 16;                       \
    ra0 = *(const f32x4v*)(ar_); ra1 = *(const f32x4v*)(ar_ + 4); ra2 = *(const f32x4v*)(ar_ + 8); ra3 = *(const f32x4v*)(ar_ + 12); \
  }
  GLM_RAW(0)
  {
    for (int gidx = 0; gidx < 36; ++gidx) {
      const int seg = gidx < 4 ? 0 : 1, c = seg ? gidx - 4 : gidx;
      const int len = seg ? SEQ : CTXL;
      const int base = seg ? b * SEQ : LAT + b * CTXL;
      float qf[16], kf[16];
      {
        unpack8v(rq0, qf); unpack8v(rq1, qf + 8);
        unpack8v(rk0, kf); unpack8v(rk1, kf + 8);
        const f32x4v al[4] = {ra0, ra1, ra2, ra3};
#pragma unroll
        for (int i = 0; i < 4; ++i) {
          BC[pp * 65 + q4 * 16 + i * 4 + 0] = __logf(al[i].x); BC[pp * 65 + q4 * 16 + i * 4 + 1] = __logf(al[i].y);
          BC[pp * 65 + q4 * 16 + i * 4 + 2] = __logf(al[i].z); BC[pp * 65 + q4 * 16 + i * 4 + 3] = __logf(al[i].w);
        }
        const unsigned vw[8] = {rv0.x, rv0.y, rv0.z, rv0.w, rv1.x, rv1.y, rv1.z, rv1.w};
#pragma unroll
        for (int i = 0; i < 8; ++i) {
          VT[(q4 * 16 + 2 * i) * 72 + pp] = (u16)(vw[i] & 0xffffu);
          VT[(q4 * 16 + 2 * i + 1) * 72 + pp] = (u16)(vw[i] >> 16);
        }
        if (gidx + 1 < 36) GLM_RAW(gidx + 1)
      }
      __syncthreads();
      if (tid < 64) {
        float run = 0.f;
#pragma unroll 8
        for (int j = 0; j < 64; ++j) { run += BC[j * 65 + tid]; BC[j * 65 + tid] = run; }
      }
      __syncthreads();
      {
        unsigned wq[8], wk[8];
#pragma unroll
        for (int i = 0; i < 8; ++i) {
          float qv[2], kv2[2];
#pragma unroll
          for (int u = 0; u < 2; ++u) {
            const int d = q4 * 16 + 2 * i + u;
            const float bcv = BC[pp * 65 + d], bl = BC[63 * 65 + d];
            const float e1 = __expf(bcv);
            qv[u] = qf[2 * i + u] * 0.125f * e1;
            kv2[u] = kf[2 * i + u] * __builtin_amdgcn_rcpf(e1);
            KDT[d * 72 + pp] = f2bf(kf[2 * i + u] * __expf(bl - bcv));
          }
          wq[i] = pack2(qv[0], qv[1]);
          wk[i] = pack2(kv2[0], kv2[1]);
        }
        *(u32x4*)(QD + pp * 72 + q4 * 16) = (u32x4){wq[0], wq[1], wq[2], wq[3]};
        *(u32x4*)(QD + pp * 72 + q4 * 16 + 8) = (u32x4){wq[4], wq[5], wq[6], wq[7]};
        *(u32x4*)(KI + pp * 72 + q4 * 16) = (u32x4){wk[0], wk[1], wk[2], wk[3]};
        *(u32x4*)(KI + pp * 72 + q4 * 16 + 8) = (u32x4){wk[4], wk[5], wk[6], wk[7]};
      }
      __syncthreads();
      if (seg == 1) {
        bf16x8 bqf[4];
#pragma unroll
        for (int ks = 0; ks < 4; ++ks) bqf[ks] = *(const bf16x8*)(QD + (it * 32 + r) * 72 + ks * 16 + hh * 8);
        f32x16 o;
#pragma unroll
        for (int i = 0; i < 16; ++i) o[i] = 0.f;
#pragma unroll
        for (int ks = 0; ks < 4; ++ks) {
          const bf16x8 a = *(const bf16x8*)(ST + (et * 32 + r) * 72 + ks * 16 + hh * 8);
          o = MFMA(a, bqf[ks], o);
        }
        for (int jt = 0; jt <= it; ++jt) {
          f32x16 sT;
#pragma unroll
          for (int i = 0; i < 16; ++i) sT[i] = 0.f;
#pragma unroll
          for (int ks = 0; ks < 4; ++ks) {
            const bf16x8 a = *(const bf16x8*)(KI + (jt * 32 + r) * 72 + ks * 16 + hh * 8);
            sT = MFMA(a, bqf[ks], sT);
          }
          if (jt == it) {
#pragma unroll
            for (int i = 0; i < 16; ++i) {
              const int jl = (i & 3) + 8 * (i >> 2) + 4 * hh;
              if (jl > r) sT[i] = 0.f;
            }
          }
#pragma unroll
          for (int sx = 0; sx < 2; ++sx) {
            u32x4 pu;
            pu.x = pack2(sT[8 * sx + 0], sT[8 * sx + 1]); pu.y = pack2(sT[8 * sx + 2], sT[8 * sx + 3]);
            pu.z = pack2(sT[8 * sx + 4], sT[8 * sx + 5]); pu.w = pack2(sT[8 * sx + 6], sT[8 * sx + 7]);
            const u16* vp = VT + (et * 32 + r) * 72 + jt * 32 + 16 * sx + 4 * hh;
            const uint2 va = *(const uint2*)(vp);
            const uint2 vb2 = *(const uint2*)(vp + 8);
            const u32x4 vu = {va.x, va.y, vb2.x, vb2.y};
            o = MFMA(__builtin_bit_cast(bf16x8, vu), __builtin_bit_cast(bf16x8, pu), o);
          }
        }
        const int pos = c * 64 + it * 32 + r;
        const int tau = dir ? len - 1 - pos : pos;
        u16* op = od + (size_t)(base + tau) * 512 + h * 128 + eh * 64 + et * 32;
#pragma unroll
        for (int g4 = 0; g4 < 4; ++g4) {
          uint2 w;
          w.x = pack2(o[4 * g4 + 0], o[4 * g4 + 1]);
          w.y = pack2(o[4 * g4 + 2], o[4 * g4 + 3]);
          *(uint2*)(op + 8 * g4 + 4 * hh) = w;
        }
      }
      {
        f32x16 kvt;
#pragma unroll
        for (int i = 0; i < 16; ++i) kvt[i] = 0.f;
#pragma unroll
        for (int ks = 0; ks < 4; ++ks) {
          const bf16x8 a = *(const bf16x8*)(VT + (et * 32 + r) * 72 + ks * 16 + hh * 8);
          const bf16x8 bk = *(const bf16x8*)(KDT + (it * 32 + r) * 72 + ks * 16 + hh * 8);
          kvt = MFMA(a, bk, kvt);
        }
        const float decay = __expf(BC[63 * 65 + it * 32 + r]);
#pragma unroll
        for (int i = 0; i < 16; ++i) Sreg[i] = Sreg[i] * decay + kvt[i];
      }
      __syncthreads();
#pragma unroll
      for (int i = 0; i < 16; ++i) {
        const int el = (i & 3) + 8 * (i >> 2) + 4 * hh;
        ST[(et * 32 + el) * 72 + it * 32 + r] = f2bf(Sreg[i]);
      }
    }
  }
}

DI void scan_post(const P& p, int layer, int vb, int nvb) {
  const int tid_ = get_tid();
  const int lane = tid_ & 63, wave = tid_ >> 6;
  const u16* z = (const u16*)(p.ws + OFF_REGB);
  u16* o0 = (u16*)(p.ws + OFF_ODIR);
  const u16* o1 = o0 + (size_t)T * 512;
  const int nrows = layer == 0 ? T : LAT;
  const int ldz = layer == 0 ? EVEN_IN : ODD_IN;
  const int goff = layer == 0 ? 2240 : 1056;
  float on[8];
#pragma unroll
  for (int j = 0; j < 8; ++j)
    on[j] = layer == 0 ? p.ev_out_norm[(lane & 7) * 8 + j] : p.od_out_norm[(lane & 15) * 8 + j];
  for (int t = vb * 4 + wave; t < nrows; t += nvb * 4) {
    float a[8], bb[8], gt[8];
    unpack8(*(const uint4*)(o0 + (size_t)t * 512 + lane * 8), a);
    unpack8(*(const uint4*)(o1 + (size_t)t * 512 + lane * 8), bb);
    unpack8(*(const uint4*)(z + (size_t)t * ldz + goff + lane * 8), gt);
    float ss = 0.f;
#pragma unroll
    for (int j = 0; j < 8; ++j) { a[j] += bb[j]; ss += a[j] * a[j]; }
    ss += __shfl_xor(ss, 1); ss += __shfl_xor(ss, 2); ss += __shfl_xor(ss, 4);
    float rms;
    if (layer == 0) rms = rsqrtf(ss * (1.f / 64.f) + EPS);
    else { ss += __shfl_xor(ss, 8); rms = rsqrtf(ss * (1.f / 128.f) + EPS); }
#pragma unroll
    for (int j = 0; j < 8; ++j) a[j] = a[j] * rms * on[j] * silu_f(gt[j]);
    *(uint4*)(o0 + (size_t)t * 512 + lane * 8) = pack8(a);
  }
}


#define XB_TMO      128
#define XB_XCNT(j)  (256  + 64 * (j))
#define XB_XSUB(j)  (1280 + 64 * (j))
#define XB_XGEN(j)  (2304 + 64 * (j))
#define XB_TOP      3328
#define XB_TOPGEN   3392
#define XB_SPIN_CAP (1u << 18)
#define LAS __attribute__((address_space(3)))
DI unsigned xb_ld(unsigned* p) { return __hip_atomic_load(p, __ATOMIC_RELAXED, __HIP_MEMORY_SCOPE_AGENT); }
DI unsigned xb_add(unsigned* p, unsigned v) { return __hip_atomic_fetch_add(p, v, __ATOMIC_RELAXED, __HIP_MEMORY_SCOPE_AGENT); }
DI unsigned xb_xcc_id() { return (unsigned)__builtin_amdgcn_s_getreg((3 << 11) | 20) & 0xFu; }
#define XB_SPIN(cond, bar) do { unsigned _sp = 0; while (cond) { __builtin_amdgcn_s_sleep(1); \
    if ((++_sp & 255u) == 0u) { if (xb_ld(&(bar)[XB_TMO])) break; if (_sp > XB_SPIN_CAP) { atomicAdd(&(bar)[XB_TMO], 1u); break; } } } } while (0)
struct XcdBarrier { unsigned* bar; unsigned x; unsigned G; unsigned nloc; unsigned nx; };
DI XcdBarrier xcd_barrier_post(unsigned* bar, unsigned G, bool member) {
  XcdBarrier b; b.bar = bar; b.x = xb_xcc_id(); b.G = G; b.nloc = 0u; b.nx = 0u;
  if (member && threadIdx.x == 0) (void)xb_add(&bar[XB_XCNT(b.x)], 1u);
  return b;
}
DI void xcd_barrier_complete(unsigned* bar, unsigned x, unsigned G, unsigned& nloc, unsigned& nx) {
  unsigned sum, cnt, mine, sp = 0u;
  for (;;) {
    sum = 0u; cnt = 0u; mine = 0u;
#pragma unroll
    for (unsigned j = 0; j < 16; ++j) { const unsigned c = xb_ld(&bar[XB_XCNT(j)]); sum += c; cnt += (c > 0u) ? 1u : 0u; mine = (j == x) ? c : mine; }
    if (sum == G) break;
    __builtin_amdgcn_s_sleep(1);
    if ((++sp & 255u) == 0u) { if (xb_ld(&bar[XB_TMO])) break; if (sp > XB_SPIN_CAP) { atomicAdd(&bar[XB_TMO], 1u); break; } }
  }
  nloc = mine > 0u ? mine : 1u; nx = cnt > 0u ? cnt : 1u;
}
DI void xcd_barrier(XcdBarrier& b) {
  asm volatile("s_waitcnt vmcnt(0)" ::: "memory");
  __syncthreads();
  if (threadIdx.x == 0) {
    unsigned* bar = b.bar;
    __builtin_amdgcn_s_waitcnt(0);
    unsigned nloc = b.nloc, nx = b.nx;
    if (nloc == 0u) { xcd_barrier_complete(bar, b.x, b.G, nloc, nx); b.nloc = nloc; b.nx = nx; }
    const unsigned old = xb_add(&bar[XB_XSUB(b.x)], 1u);
    const unsigned gen = old / nloc;
    if (old + 1u == (gen + 1u) * nloc) {
      __builtin_amdgcn_fence(__ATOMIC_RELEASE, "agent");
      asm volatile("s_waitcnt vmcnt(0)" ::: "memory");
      const unsigned og = xb_add(&bar[XB_TOP], 1u);
      const unsigned tg = og / nx;
      if (og + 1u == (tg + 1u) * nx) xb_add(&bar[XB_TOPGEN], 1u);
      else XB_SPIN(xb_ld(&bar[XB_TOPGEN]) == tg, bar);
      __builtin_amdgcn_fence(__ATOMIC_ACQUIRE, "agent");
      xb_add(&bar[XB_XGEN(b.x)], 1u);
      asm volatile("s_waitcnt vmcnt(0)" ::: "memory");
    } else {
      XB_SPIN(xb_ld(&bar[XB_XGEN(b.x)]) == gen, bar);
      __builtin_amdgcn_fence(__ATOMIC_ACQUIRE, "agent");
      asm volatile("s_waitcnt vmcnt(0)" ::: "memory");
    }
  }
  __syncthreads();
}

DI void ffn_phases(const P& p, XcdBarrier& xb, int layer, int s, int M, char* smem, int vb, int nvb) {
  char* ws = p.ws;
  {
    GemmDesc g = gemm_simple((const u16*)(ws + OFF_REGA), 1024, (const u16*)(ws + OFF_WGU) + (size_t)s * 5632 * 1024,
                             1024, M, 5632);
    g.o16 = (u16*)(ws + OFF_REGB); g.ldo = DFF;
    gemm_auto<EPI_SWIGLU>(g, M, smem, vb, nvb);
  }
  xcd_barrier(xb);
  {
    GemmDesc g = gemm_simple((const u16*)(ws + OFF_REGB), DFF, (const u16*)(ws + OFF_WDN) + (size_t)s * 1024 * 2816,
                             DFF, M, 1024);
    g.xres = p.out; g.hres = (float*)(ws + OFF_RH);
    g.mod = (const float*)(ws + OFF_MODS) + (size_t)layer * 9 * 9216;
    g.gidx = s == 0 ? 2 : 8; g.coef = 0.5f;
    gemm_auto<EPI_RES>(g, M, smem, vb, nvb);
  }
  xcd_barrier(xb);
}

__global__ void __launch_bounds__(NTHR, 2) mega(P p) {
  extern __shared__ __attribute__((aligned(16))) char smem[];
  cg::grid_group grid = cg::this_grid();
  const int vb = blockIdx.x, nvb = gridDim.x;
  char* ws = p.ws;
  XcdBarrier xb = xcd_barrier_post((unsigned*)(ws + OFF_BAR), gridDim.x, true);
  const bool subgrid = nvb >= 512;
  XcdBarrier xb2 = xcd_barrier_post((unsigned*)(ws + OFF_BAR) + 4096, gridDim.x - 256, subgrid && vb >= 256);
  if (p.ws == nullptr) grid.sync();

  mods_phase(p, smem, vb, nvb);
  __syncthreads();
  convert_weights(p, 0, smem, vb, nvb, 0);
  xcd_barrier(xb);

  for (int layer = 0; layer < 2; ++layer) {
    const bool ctx_out = layer == 0;
    if (layer == 1) convert_weights(p, 1, smem, vb, nvb, 0);
    normmod_phase(p, layer, 0, T, layer == 0, vb, nvb);
    xcd_barrier(xb);
    ffn_phases(p, xb, layer, 0, T, smem, vb, nvb);
    normmod_phase(p, layer, 1, T, false, vb, nvb);
    xcd_barrier(xb);
    {
      GemmDesc g = gemm_simple((const u16*)(ws + OFF_REGA), 1024, (const u16*)(ws + OFF_WIN), 1024, T,
                               layer == 0 ? EVEN_PAD : ODD_PAD);
      g.o16 = (u16*)(ws + OFF_REGB);
      g.ldo = layer == 0 ? EVEN_IN : ODD_IN;
      g.nreal = g.ldo;
      g.side = (float*)(ws + OFF_SIDE);
      g.slo = layer == 0 ? 2208 : 1024;
      gemm_auto<EPI_STORE>(g, T, smem, vb, nvb);
    }
    xcd_barrier(xb);
    if (layer == 0) {
      const bool split0 = subgrid;
      const int svb = split0 ? vb - 256 : vb, snvb = split0 ? nvb - 256 : nvb;
      if (!split0 || vb < 256)
        for (int cid = vb; cid < 256; cid += (split0 ? 256 : nvb)) gdn_chain(p, cid, smem);
      __syncthreads();
      if (!split0 || vb >= 256) {
        XcdBarrier& bs = split0 ? xb2 : xb;
        {
          GemmDesc g = gemm_simple((const u16*)(ws + OFF_REGB), EVEN_IN, (const u16*)(ws + OFF_WQUP), 384, T, 768);
          g.o16 = (u16*)(ws + OFF_QB); g.ldo = 768; g.nreal = 768;
          gemm_auto<EPI_STORE>(g, T, smem, svb, snvb);
          GemmDesc g2 = gemm_simple((const u16*)(ws + OFF_REGB) + 384, EVEN_IN, (const u16*)(ws + OFF_WKVUP), 256, T, 1024);
          g2.o16 = (u16*)(ws + OFF_REGA); g2.ldo = 1024; g2.nreal = 1024;
          gemm_auto<EPI_STORE>(g2, T, smem, svb, snvb);
        }
        xcd_barrier(bs);
        mla_finalize(p, smem, svb, snvb);
        xcd_barrier(bs);
        const u16* Q = (const u16*)(ws + OFF_QB);
        const u16* Kb = (const u16*)(ws + OFF_KB);
        const u16* KV = (const u16*)(ws + OFF_REGA);
        for (int it = svb; it < 1024 + 128; it += snvb) {
          if (it < 1024) {
            const int b = it >> 7, h = (it >> 4) & 7, qt = it & 15;
            attn_item<96, false>(Q, 768, h * 96, Kb, 768, h * 96, KV, 1024, h * 128 + 64, b * SEQ + qt * 128, qt * 128,
                                 LAT + b * CTXL, b * SEQ, 0, 32, 0.f, (u16*)(ws + OFF_QB), 768, h * 96, smem);
          } else {
            const int j = it - 1024;
            const int b = j >> 4, h = (j >> 1) & 7, qt = j & 1;
            attn_item<96, false>(Q, 768, h * 96, Kb, 768, h * 96, KV, 1024, h * 128 + 64, LAT + b * CTXL + qt * 128, 0,
                                 LAT + b * CTXL, b * SEQ, 0, 0, 0.f, (u16*)(ws + OFF_QB), 768, h * 96, smem);
          }
        }
        __syncthreads();
        convert_weights(p, 0, smem, svb, snvb, 1);
      }
      xcd_barrier(xb);
      scan_post(p, 0, vb, nvb);
      xcd_barrier(xb);
      {
        GemmDesc g = gemm_simple((const u16*)(ws + OFF_QB), 768, (const u16*)(ws + OFF_WOUT), 1024, T, 1024);
        g.kstep0 = 96; g.ksplit = 8; g.A1 = (const u16*)(ws + OFF_ODIR); g.lda1 = 512;
        g.xres = p.out; g.hres = (float*)(ws + OFF_RH);
        g.mod = (const float*)(ws + OFF_MODS); g.gidx = 5; g.coef = 1.f;
        gemm_auto<EPI_RES>(g, T, smem, vb, nvb);
      }
      xcd_barrier(xb);
    } else {
      swa_finalize(p, smem, vb, nvb);
      xcd_barrier(xb);
      const bool split1 = nvb >= 256;
      if (!split1 || vb < 128)
        for (int cid = vb; cid < 128; cid += (split1 ? 128 : nvb)) gla_chain_mfma(p, cid, smem);
      __syncthreads();
      if (!split1 || vb >= 128)
      {
        const u16* Q = (const u16*)(ws + OFF_QB);
        const u16* Kb = (const u16*)(ws + OFF_KB);
        const u16* z = (const u16*)(ws + OFF_REGB);
        for (int it = (split1 ? vb - 128 : vb); it < 1024; it += (split1 ? nvb - 128 : nvb)) {
          const int b = it >> 7, h = (it >> 4) & 7, qt = it & 15;
          const int g2 = h >> 2;
          const int q0 = qt * 128;
          const int lo = (q0 - 128 < 0 ? 0 : q0 - 128) >> 6;
          const int hi = (q0 + 256 > SEQ ? SEQ : q0 + 256) >> 6;
          attn_item<64, true>(Q, 512, h * 64, Kb, 128, g2 * 64, z, ODD_IN, 2208 + g2 * 64, b * SEQ + q0, q0,
                              LAT + b * CTXL, b * SEQ, lo, hi, p.od_sink[h] * LOG2E, (u16*)(ws + OFF_REGA), 512, h * 64,
                              smem);
        }
        __syncthreads();
        convert_weights(p, 1, smem, split1 ? vb - 128 : vb, split1 ? nvb - 128 : nvb, 1);
      }
      xcd_barrier(xb);
      scan_post(p, 1, vb, nvb);
      xcd_barrier(xb);
      {
        GemmDesc g = gemm_simple((const u16*)(ws + OFF_ODIR), 512, (const u16*)(ws + OFF_WOUT), 1024, LAT, 1024);
        g.kstep0 = 64; g.ksplit = 8; g.A1 = (const u16*)(ws + OFF_REGA); g.lda1 = 512;
        g.xres = p.out; g.hres = (float*)(ws + OFF_RH);
        g.mod = (const float*)(ws + OFF_MODS) + (size_t)9 * 9216; g.gidx = 5; g.coef = 1.f;
        gemm_auto<EPI_RES>(g, LAT, smem, vb, nvb);
      }
      xcd_barrier(xb);
    }
    const int M2 = ctx_out ? T : LAT;
    normmod_phase(p, layer, 2, M2, false, vb, nvb);
    xcd_barrier(xb);
    ffn_phases(p, xb, layer, 1, M2, smem, vb, nvb);
  }
}

extern "C" void kernel_launch(void* const* d_in, const int* in_sizes, int n_in, void* d_out, int out_size, void* d_ws,
                              size_t ws_size, hipStream_t stream) {
  static int grid_blocks = 0;
  if (!grid_blocks) {
    int dev = 0, cus = 0, per_cu = 0;
    hipGetDevice(&dev);
    hipDeviceGetAttribute(&cus, hipDeviceAttributeMultiprocessorCount, dev);
    hipFuncSetAttribute((const void*)mega, hipFuncAttributeMaxDynamicSharedMemorySize, SMEM_BYTES);
    hipOccupancyMaxActiveBlocksPerMultiprocessor(&per_cu, mega, NTHR, SMEM_BYTES);
    if (per_cu > 2) per_cu = 2;
    grid_blocks = cus * per_cu;
    if (ws_size < WS_NEED) fprintf(stderr, "workspace too small: %zu < %zu\n", ws_size, (size_t)WS_NEED);
  }
  P p{};
  const float* const* in = (const float* const*)d_in;
  p.x = in[0]; p.c = in[1]; p.ctx = in[2]; p.c_ctx = in[3]; p.ada_w = in[4]; p.ada_b = in[5]; p.norm_g = in[6];
  p.ffn_g = in[7]; p.ffn_u = in[8]; p.ffn_d = in[9];
  p.ev_w_in = in[10]; p.ev_q_a_norm = in[11]; p.ev_w_q_up = in[12]; p.ev_kv_a_norm = in[13]; p.ev_w_kv_up = in[14];
  p.ev_q_norm = in[15]; p.ev_k_norm = in[16]; p.ev_conv = in[17]; p.ev_a_log = in[18]; p.ev_dt_bias = in[19];
  p.ev_out_norm = in[20]; p.ev_w_out = in[21];
  p.od_w_in = in[22]; p.od_w2 = in[23]; p.od_gb = in[24]; p.od_out_norm = in[25]; p.od_q_norm = in[26];
  p.od_k_norm = in[27]; p.od_sink = in[28]; p.od_w_out = in[29];
  p.out = (float*)d_out;
  p.ws = (char*)d_ws;
  hipMemsetAsync((char*)d_ws + OFF_BAR, 0, 32768, stream);
  void* args[] = {&p};
  hipError_t e = hipLaunchCooperativeKernel((const void*)mega, dim3(grid_blocks), dim3(NTHR), args, SMEM_BYTES, stream);
  if (e != hipSuccess) fprintf(stderr, "cooperative launch failed: %s (grid %d)\n", hipGetErrorString(e), grid_blocks);
}
```

```cpp
#include <hip/hip_runtime.h>
#include <hip/hip_cooperative_groups.h>
#include <cstdio>
namespace cg = cooperative_groups;

#define DI __device__ __forceinline__
typedef unsigned short u16;
typedef short bf16x8 __attribute__((ext_vector_type(8)));
typedef float f32x16 __attribute__((ext_vector_type(16)));
typedef unsigned u32x4 __attribute__((ext_vector_type(4)));
typedef float f32x2 __attribute__((ext_vector_type(2)));
typedef float f32x4v __attribute__((ext_vector_type(4)));
#define LAS3 __attribute__((address_space(3)))
#define MFMA(a, b, c) __builtin_amdgcn_mfma_f32_32x32x16_bf16((a), (b), (c), 0, 0, 0)

constexpr int D = 1024, NB = 8, SEQ = 2048, CTXL = 256;
constexpr int LAT = NB * SEQ, NCTX = NB * CTXL, T = LAT + NCTX;
constexpr int DFF = 2816;
constexpr int EVEN_IN = 2752, EVEN_PAD = 2816, ODD_IN = 2336, ODD_PAD = 2432;
constexpr float EPS = 1e-6f;
constexpr float LOG2E = 1.4426950408889634f;
constexpr int NTHR = 256;
constexpr int SMEM_BYTES = 81920;

constexpr size_t OFF_WGU = 0;
constexpr size_t OFF_WDN = OFF_WGU + 2ull * 5632 * 1024 * 2;
constexpr size_t OFF_WIN = OFF_WDN + 2ull * 1024 * 2816 * 2;
constexpr size_t OFF_WQUP = OFF_WIN + 2816ull * 1024 * 2;
constexpr size_t OFF_WKVUP = OFF_WQUP + 768ull * 384 * 2;
constexpr size_t OFF_WOUT = OFF_WKVUP + 1024ull * 256 * 2;
constexpr size_t OFF_MODS = OFF_WOUT + 1024ull * 1024 * 2;
constexpr size_t OFF_RH = OFF_MODS + 2ull * 9 * 9216 * 4;
constexpr size_t OFF_SIDE = OFF_RH + 2048ull * 1024 * 4;
constexpr size_t OFF_REGA = OFF_SIDE + (size_t)T * 32 * 4;
constexpr size_t OFF_REGB = OFF_REGA + (size_t)T * 1024 * 2;
constexpr size_t OFF_QB = OFF_REGB + (size_t)T * 2816 * 2;
constexpr size_t OFF_KB = OFF_QB + (size_t)T * 768 * 2;
constexpr size_t OFF_ODIR = OFF_KB + (size_t)T * 768 * 2;
constexpr size_t OFF_BAR = OFF_ODIR + 2ull * T * 512 * 2;
constexpr size_t WS_NEED = OFF_BAR + 32768;

struct P {
  const float *x, *c, *ctx, *c_ctx, *ada_w, *ada_b, *norm_g, *ffn_g, *ffn_u, *ffn_d;
  const float *ev_w_in, *ev_q_a_norm, *ev_w_q_up, *ev_kv_a_norm, *ev_w_kv_up, *ev_q_norm, *ev_k_norm, *ev_conv,
      *ev_a_log, *ev_dt_bias, *ev_out_norm, *ev_w_out;
  const float *od_w_in, *od_w2, *od_gb, *od_out_norm, *od_q_norm, *od_k_norm, *od_sink, *od_w_out;
  float* out;
  char* ws;
};

DI int get_tid() {
  int t = threadIdx.x;
  asm volatile("" : "+v"(t));
  return t;
}
DI u16 f2bf(float x) {
  return __builtin_bit_cast(u16, (__bf16)x);
}
DI float bf2f(u16 v) { return __uint_as_float(((unsigned)v) << 16); }
typedef __bf16 bf16x2v __attribute__((ext_vector_type(2)));
DI unsigned pack2(float a, float b) {
  const f32x2 v = {a, b};
  return __builtin_bit_cast(unsigned, __builtin_convertvector(v, bf16x2v));
}
DI float bflo(unsigned w) { return __uint_as_float(w << 16); }
DI float bfhi(unsigned w) { return __uint_as_float(w & 0xffff0000u); }
DI void unpack8(uint4 v, float* f) {
  f[0] = bflo(v.x); f[1] = bfhi(v.x); f[2] = bflo(v.y); f[3] = bfhi(v.y);
  f[4] = bflo(v.z); f[5] = bfhi(v.z); f[6] = bflo(v.w); f[7] = bfhi(v.w);
}
DI void unpack8v(u32x4 v, float* f) {
  f[0] = bflo(v.x); f[1] = bfhi(v.x); f[2] = bflo(v.y); f[3] = bfhi(v.y);
  f[4] = bflo(v.z); f[5] = bfhi(v.z); f[6] = bflo(v.w); f[7] = bfhi(v.w);
}
DI uint4 pack8(const float* f) {
  uint4 v;
  v.x = pack2(f[0], f[1]); v.y = pack2(f[2], f[3]); v.z = pack2(f[4], f[5]); v.w = pack2(f[6], f[7]);
  return v;
}
DI float wave_sum(float v) {
  v += __shfl_xor(v, 32); v += __shfl_xor(v, 16); v += __shfl_xor(v, 8);
  v += __shfl_xor(v, 4); v += __shfl_xor(v, 2); v += __shfl_xor(v, 1);
  return v;
}
DI float quad_sum(float v) {
  v += __builtin_bit_cast(float, __builtin_amdgcn_mov_dpp(__builtin_bit_cast(int, v), 0xB1, 0xF, 0xF, true));
  v += __builtin_bit_cast(float, __builtin_amdgcn_mov_dpp(__builtin_bit_cast(int, v), 0x4E, 0xF, 0xF, true));
  return v;
}
DI float row16_sum(float v) {
  v += __builtin_bit_cast(float, __builtin_amdgcn_mov_dpp(__builtin_bit_cast(int, v), 0xB1, 0xF, 0xF, true));
  v += __builtin_bit_cast(float, __builtin_amdgcn_mov_dpp(__builtin_bit_cast(int, v), 0x4E, 0xF, 0xF, true));
  v += __builtin_bit_cast(float, __builtin_amdgcn_mov_dpp(__builtin_bit_cast(int, v), 0x141, 0xF, 0xF, true));
  v += __builtin_bit_cast(float, __builtin_amdgcn_mov_dpp(__builtin_bit_cast(int, v), 0x140, 0xF, 0xF, true));
  return v;
}
DI float row8_sum(float v) {
  v += __builtin_bit_cast(float, __builtin_amdgcn_mov_dpp(__builtin_bit_cast(int, v), 0xB1, 0xF, 0xF, true));
  v += __builtin_bit_cast(float, __builtin_amdgcn_mov_dpp(__builtin_bit_cast(int, v), 0x4E, 0xF, 0xF, true));
  v += __builtin_bit_cast(float, __builtin_amdgcn_mov_dpp(__builtin_bit_cast(int, v), 0x141, 0xF, 0xF, true));
  return v;
}
DI void wave_lds_sync() {
  asm volatile("s_waitcnt lgkmcnt(0)" ::: "memory");
  __builtin_amdgcn_wave_barrier();
}
DI float silu_f(float x) { return x * __builtin_amdgcn_rcpf(1.f + __expf(-x)); }
DI float sigmoid_f(float x) { return __builtin_amdgcn_rcpf(1.f + __expf(-x)); }
DI float softplus_f(float x) { return x > 20.f ? x : log1pf(__expf(x)); }

DI void conv_tile(const float* __restrict__ src, int N, u16* __restrict__ dst, int ldd, int k0, int n0, int mode,
                  const float* __restrict__ kscale, float* tl) {
  const int t = get_tid();
  const int r = t >> 4, c4 = (t & 15) * 4;
#pragma unroll
  for (int i = 0; i < 4; ++i) {
    const int k = r + 16 * i;
    float4 v = make_float4(0.f, 0.f, 0.f, 0.f);
    if (n0 + c4 < N) v = *(const float4*)(src + (size_t)(k0 + k) * N + n0 + c4);
    if (kscale) { const float s = kscale[k0 + k]; v.x *= s; v.y *= s; v.z *= s; v.w *= s; }
    float* q = tl + k * 65 + c4;
    q[0] = v.x; q[1] = v.y; q[2] = v.z; q[3] = v.w;
  }
  __syncthreads();
  const int n = t >> 2, ks = (t & 3) * 16;
  unsigned w[8];
#pragma unroll
  for (int j = 0; j < 8; ++j) w[j] = pack2(tl[(ks + 2 * j) * 65 + n], tl[(ks + 2 * j + 1) * 65 + n]);
  const int nn = n0 + n;
  const int drow = mode == 0 ? nn : ((nn >> 5) * 64 + (nn & 31) + (mode == 2 ? 32 : 0));
  uint4* d = (uint4*)(dst + (size_t)drow * ldd + k0 + ks);
  d[0] = make_uint4(w[0], w[1], w[2], w[3]);
  d[1] = make_uint4(w[4], w[5], w[6], w[7]);
  __syncthreads();
}

DI void convert_weights(const P& p, int layer, char* smem, int vb, int nvb, int part) {
  float* tl = (float*)smem;
  char* ws = p.ws;
  const int nFF = 704;
  const int nIn = (layer == 0 ? EVEN_PAD : ODD_PAD) / 64 * 16;
  const int nQ = layer == 0 ? 72 : 0, nKV = layer == 0 ? 64 : 0;
  const int nEarly = 3 * nFF + nIn + nQ + nKV, nLate = 3 * nFF + 256;
  const int total = part == 0 ? nEarly : nLate;
  for (int job = vb; job < total; job += nvb) {
    int j = part == 0 ? (job < 3 * nFF ? job : job + 3 * nFF)
                      : (job < 3 * nFF ? job + 3 * nFF : 6 * nFF + nIn + nQ + nKV + (job - 3 * nFF));
    if (j < 6 * nFF) {
      const int s = j / (3 * nFF);
      int jj = j % (3 * nFF);
      const int which = jj / nFF;
      jj %= nFF;
      const size_t woff = ((size_t)layer * 2 + s) * 1024 * 2816;
      if (which < 2) {
        const float* src = (which == 0 ? p.ffn_g : p.ffn_u) + woff;
        u16* dst = (u16*)(ws + OFF_WGU) + (size_t)s * 5632 * 1024;
        conv_tile(src, 2816, dst, 1024, (jj / 44) * 64, (jj % 44) * 64, 1 + which, nullptr, tl);
      } else {
        const float* src = p.ffn_d + woff;
        u16* dst = (u16*)(ws + OFF_WDN) + (size_t)s * 1024 * 2816;
        conv_tile(src, 1024, dst, 2816, (jj / 16) * 64, (jj % 16) * 64, 0, nullptr, tl);
      }
      continue;
    }
    j -= 6 * nFF;
    if (j < nIn) {
      const int N = layer == 0 ? EVEN_IN : ODD_IN;
      const int ntn = (layer == 0 ? EVEN_PAD : ODD_PAD) / 64;
      const float* src = layer == 0 ? p.ev_w_in : p.od_w_in;
      conv_tile(src, N, (u16*)(ws + OFF_WIN), 1024, (j / ntn) * 64, (j % ntn) * 64, 0, nullptr, tl);
      continue;
    }
    j -= nIn;
    if (j < nQ) {
      conv_tile(p.ev_w_q_up, 768, (u16*)(ws + OFF_WQUP), 384, (j / 12) * 64, (j % 12) * 64, 0, p.ev_q_a_norm, tl);
      continue;
    }
    j -= nQ;
    if (j < nKV) {
      conv_tile(p.ev_w_kv_up, 1024, (u16*)(ws + OFF_WKVUP), 256, (j / 16) * 64, (j % 16) * 64, 0, p.ev_kv_a_norm, tl);
      continue;
    }
    j -= nKV;
    {
      const float* src = layer == 0 ? p.ev_w_out : p.od_w_out;
      conv_tile(src, 1024, (u16*)(ws + OFF_WOUT), 1024, (j / 16) * 64, (j % 16) * 64, 0, nullptr, tl);
    }
  }
}

DI void mods_phase(const P& p, char* smem, int vb, int nvb) {
  float* sc = (float*)smem;
  float* red = sc + 9 * 1024;
  float* mods = (float*)(p.ws + OFF_MODS);
  const int t = get_tid();
  bool loaded = false;
  for (int job = vb; job < 576; job += nvb) {
    if (!loaded) {
      for (int i = t; i < 9 * 1024; i += NTHR) {
        const float v = i < 8192 ? p.c[i] : p.c_ctx[i - 8192];
        sc[i] = silu_f(v);
      }
      loaded = true;
      __syncthreads();
    }
    const int l = job / 288, n0 = (job % 288) * 32;
    const int c4 = (t & 7) * 4, ksl = t >> 3;
    float4 acc[9];
#pragma unroll
    for (int r = 0; r < 9; ++r) acc[r] = make_float4(0.f, 0.f, 0.f, 0.f);
    const float* w = p.ada_w + (size_t)l * 1024 * 9216 + n0 + c4;
#pragma unroll 8
    for (int kk = 0; kk < 32; ++kk) {
      const int k = ksl * 32 + kk;
      const float4 wv = *(const float4*)(w + (size_t)k * 9216);
#pragma unroll
      for (int r = 0; r < 9; ++r) {
        const float sv = sc[r * 1024 + k];
        acc[r].x += sv * wv.x; acc[r].y += sv * wv.y; acc[r].z += sv * wv.z; acc[r].w += sv * wv.w;
      }
    }
#pragma unroll
    for (int r = 0; r < 9; ++r) *(float4*)(red + (ksl * 9 + r) * 32 + c4) = acc[r];
    __syncthreads();
    for (int i = t; i < 9 * 32; i += NTHR) {
      const int r = i >> 5, cc = i & 31;
      float v = p.ada_b[(size_t)l * 9216 + n0 + cc];
#pragma unroll
      for (int sl = 0; sl < 32; ++sl) v += red[(sl * 9 + r) * 32 + cc];
      mods[((size_t)l * 9 + r) * 9216 + n0 + cc] = v;
    }
    __syncthreads();
  }
}

DI void normmod_phase(const P& p, int layer, int which, int nrows, bool first, int vb, int nvb) {
  const int tid_ = get_tid();
  const int lane = tid_ & 63, wave = tid_ >> 6;
  u16* dst = (u16*)(p.ws + OFF_REGA);
  float* rh = (float*)(p.ws + OFF_RH);
  const float* mods = (const float*)(p.ws + OFF_MODS) + (size_t)layer * 9 * 9216;
  const float* g = p.norm_g + ((size_t)layer * 3 + which) * 1024;
  const int shift_i = which * 3, scale_i = which * 3 + 1;
  const int nw = nvb * 4;
  const int per = (nrows + nw - 1) / nw;
  const int row0 = (vb * 4 + wave) * per;
  const int row1 = row0 + per < nrows ? row0 + per : nrows;
  f32x4v gg[4], sh[4], sc1[4];
#pragma unroll
  for (int i = 0; i < 4; ++i) {
    gg[i] = *(const f32x4v*)(g + i * 256 + lane * 4);
    sh[i] = (f32x4v){0.f, 0.f, 0.f, 0.f};
    sc1[i] = (f32x4v){1.f, 1.f, 1.f, 1.f};
  }
  int crg = -1;
  for (int row = row0; row < row1; ++row) {
    const float* src;
    float* res = row < LAT ? p.out + (size_t)row * 1024 : rh + (size_t)(row - LAT) * 1024;
    if (first) src = row < LAT ? p.x + (size_t)row * 1024 : p.ctx + (size_t)(row - LAT) * 1024;
    else src = res;
    const int rg = row < LAT ? (row >> 11) : 8;
    if (rg != crg) {
      const float* mrow = mods + (size_t)rg * 9216;
#pragma unroll
      for (int i = 0; i < 4; ++i) {
        sh[i] = *(const f32x4v*)(mrow + shift_i * 1024 + i * 256 + lane * 4);
        sc1[i] = *(const f32x4v*)(mrow + scale_i * 1024 + i * 256 + lane * 4) + 1.f;
        sc1[i] *= gg[i];
      }
      crg = rg;
    }
    f32x4v v[4];
    float ss = 0.f;
#pragma unroll
    for (int i = 0; i < 4; ++i) {
      v[i] = *(const f32x4v*)(src + i * 256 + lane * 4);
      ss += v[i].x * v[i].x + v[i].y * v[i].y + v[i].z * v[i].z + v[i].w * v[i].w;
    }
    ss = wave_sum(ss);
    const float rinv = rsqrtf(ss * (1.f / 1024.f) + EPS);
#pragma unroll
    for (int i = 0; i < 4; ++i) {
      const int col = i * 256 + lane * 4;
      if (first) *(f32x4v*)(res + col) = v[i];
      const f32x4v y = v[i] * rinv * sc1[i] + sh[i];
      uint2 o;
      o.x = pack2(y.x, y.y); o.y = pack2(y.z, y.w);
      *(uint2*)(dst + (size_t)row * 1024 + col) = o;
    }
  }
}

struct GemmDesc {
  const u16* A0; int lda0; int kstep0; int ksplit;
  const u16* A1; int lda1;
  const u16* Bt; int K; int nM; int nN;
  u16* o16; int ldo; int nreal; float* side; int slo;
  float* xres; float* hres; const float* mod; int gidx; float coef;
};
constexpr int EPI_SWIGLU = 0, EPI_RES = 1, EPI_STORE = 2;

template <int EPI, int MI>
DI void gemm_tile(const GemmDesc& g, int tm, int tn, char* smem) {
  constexpr int BM = 64 * MI, ABYTES = BM * 128;
  char* As = smem;
  char* Bs = smem + 2 * ABYTES;
  const int tid = get_tid(), lane = tid & 63, wave = tid >> 6, r = lane & 31, hh = lane >> 5;
  const int wm = wave >> 1, wn = wave & 1;
  const int m0 = tm * BM, n0 = tn * 128;
  const int nk = g.K >> 6;
  f32x16 acc[MI][2];
#pragma unroll
  for (int a = 0; a < MI; ++a)
#pragma unroll
    for (int b = 0; b < 2; ++b)
#pragma unroll
      for (int i = 0; i < 16; ++i) acc[a][b][i] = 0.f;
  const int srow = tid >> 3;
  const int schunk = (tid & 7) ^ ((srow & 7) ^ ((srow >> 3) & 3));
#define G_GLDS(KT, BUF)                                                                               \
  {                                                                                                   \
    const int kt_ = (KT);                                                                             \
    const u16* Ab_; int lda_;                                                                         \
    if (kt_ < g.ksplit) { Ab_ = g.A0 + kt_ * g.kstep0; lda_ = g.lda0; }                              \
    else { Ab_ = g.A1 + (kt_ - g.ksplit) * 64; lda_ = g.lda1; }                                       \
    const u16* pa_ = Ab_ + (size_t)(m0 + srow) * lda_ + schunk * 8;                                   \
    const u16* pb_ = g.Bt + (size_t)(n0 + srow) * g.K + kt_ * 64 + schunk * 8;                        \
    char* la_ = As + (BUF) * ABYTES + tid * 16;                                                       \
    char* lb_ = Bs + (BUF) * 16384 + tid * 16;                                                        \
    _Pragma("unroll") for (int i = 0; i < 2 * MI; ++i)                                                \
      __builtin_amdgcn_global_load_lds((const unsigned*)(pa_ + (size_t)(32 * i) * lda_),             \
                                       (LAS3 unsigned*)(la_ + i * 4096), 16, 0, 0);                   \
    _Pragma("unroll") for (int i = 0; i < 4; ++i)                                                     \
      __builtin_amdgcn_global_load_lds((const unsigned*)(pb_ + (size_t)(32 * i) * g.K),              \
                                       (LAS3 unsigned*)(lb_ + i * 4096), 16, 0, 0);                   \
  }
  const int rowA = wm * (32 * MI) + r, rowB = wn * 64 + r;
  const int hk = hh ^ ((r & 7) ^ ((r >> 3) & 3));
#define G_COMPUTE(BUF)                                                                                \
  {                                                                                                   \
    const char* Ab = As + (BUF) * ABYTES + rowA * 128;                                                \
    const char* Bb = Bs + (BUF) * 16384 + rowB * 128;                                                 \
    _Pragma("unroll") for (int ks = 0; ks < 4; ++ks) {                                                \
      const int oc = (hk ^ (ks * 2)) << 4;                                                            \
      const bf16x8 b0 = *(const bf16x8*)(Bb + oc);                                                    \
      const bf16x8 b1 = *(const bf16x8*)(Bb + 32 * 128 + oc);                                         \
      _Pragma("unroll") for (int mi = 0; mi < MI; ++mi) {                                             \
        const bf16x8 a0 = *(const bf16x8*)(Ab + mi * 32 * 128 + oc);                                  \
        acc[mi][0] = MFMA(a0, b0, acc[mi][0]);                                                        \
        acc[mi][1] = MFMA(a0, b1, acc[mi][1]);                                                        \
      }                                                                                               \
    }                                                                                                 \
  }
  G_GLDS(0, 0);
  asm volatile("s_waitcnt vmcnt(0)" ::: "memory");
  __syncthreads();
  for (int kt = 0; kt < nk; kt += 2) {
    if (kt + 1 < nk) G_GLDS(kt + 1, 1);
    G_COMPUTE(0);
    asm volatile("s_waitcnt vmcnt(0)" ::: "memory");
    __syncthreads();
    if (kt + 1 < nk) {
      if (kt + 2 < nk) G_GLDS(kt + 2, 0);
      G_COMPUTE(1);
      asm volatile("s_waitcnt vmcnt(0)" ::: "memory");
      __syncthreads();
    }
  }
#undef G_GLDS
#undef G_COMPUTE
  if (EPI == EPI_SWIGLU) {
    u16* es = (u16*)smem;
#pragma unroll
    for (int mi = 0; mi < MI; ++mi)
#pragma unroll
      for (int i = 0; i < 16; ++i) {
        const int lrow = wm * (32 * MI) + mi * 32 + (i & 3) + 8 * (i >> 2) + 4 * hh;
        es[lrow * 64 + wn * 32 + r] = f2bf(silu_f(acc[mi][0][i]) * acc[mi][1][i]);
      }
    __syncthreads();
#pragma unroll
    for (int j = 0; j < 2 * MI; ++j) {
      const int lrow = (tid >> 3) + 32 * j, ch = tid & 7;
      const u32x4 v = *(const u32x4*)(es + lrow * 64 + ch * 8);
      *(u32x4*)(g.o16 + (size_t)(m0 + lrow) * g.ldo + (n0 >> 1) + ch * 8) = v;
    }
    __syncthreads();
  } else if (EPI == EPI_RES) {
    float* es = (float*)smem;
    const int c4 = (tid & 31) * 4;
    const int rgA = m0 < LAT ? (m0 >> 11) : 8;
    const int mlast = m0 + BM - 1;
    const int rgB = mlast < LAT ? (mlast >> 11) : 8;
    const f32x4v m4a = *(const f32x4v*)(g.mod + (size_t)rgA * 9216 + g.gidx * 1024 + n0 + c4);
    const f32x4v m4b = *(const f32x4v*)(g.mod + (size_t)rgB * 9216 + g.gidx * 1024 + n0 + c4);
#pragma unroll
    for (int mi = 0; mi < MI; ++mi) {
#pragma unroll
      for (int ni = 0; ni < 2; ++ni)
#pragma unroll
        for (int i = 0; i < 16; ++i) {
          const int lrow = wm * 32 + (i & 3) + 8 * (i >> 2) + 4 * hh;
          es[lrow * 128 + wn * 64 + ni * 32 + r] = acc[mi][ni][i];
        }
      __syncthreads();
#pragma unroll 4
      for (int j = 0; j < 8; ++j) {
        const int lrow = (tid >> 5) + 8 * j;
        const int grow = m0 + (lrow >> 5) * (32 * MI) + mi * 32 + (lrow & 31);
        const f32x4v a4 = *(const f32x4v*)(es + lrow * 128 + c4);
        const int rg = grow < LAT ? (grow >> 11) : 8;
        const f32x4v m4 = rg == rgA ? m4a : m4b;
        float* rp = (grow < LAT ? g.xres + (size_t)grow * 1024 : g.hres + (size_t)(grow - LAT) * 1024) + n0 + c4;
        f32x4v x4 = *(const f32x4v*)rp;
        x4 += (m4 * a4) * g.coef;
        *(f32x4v*)rp = x4;
      }
      __syncthreads();
    }
  } else {
    u16* es = (u16*)smem;
#pragma unroll
    for (int mi = 0; mi < MI; ++mi)
#pragma unroll
      for (int ni = 0; ni < 2; ++ni)
#pragma unroll
        for (int i = 0; i < 16; ++i) {
          const int lrow = wm * (32 * MI) + mi * 32 + (i & 3) + 8 * (i >> 2) + 4 * hh;
          const int col = n0 + wn * 64 + ni * 32 + r;
          const float v = acc[mi][ni][i];
          es[lrow * 128 + wn * 64 + ni * 32 + r] = f2bf(v);
          if (g.side != nullptr && col >= g.slo && col < g.slo + 32) g.side[(size_t)(m0 + lrow) * 32 + col - g.slo] = v;
        }
    __syncthreads();
#pragma unroll
    for (int j = 0; j < 4 * MI; ++j) {
      const int lrow = (tid >> 4) + 16 * j, ch = tid & 15;
      const int col = n0 + ch * 8;
      if (col < g.nreal) *(u32x4*)(g.o16 + (size_t)(m0 + lrow) * g.ldo + col) = *(const u32x4*)(es + lrow * 128 + ch * 8);
    }
    __syncthreads();
  }
}

template <int EPI, int MI>
DI void gemm_phase(const GemmDesc& g, char* smem, int vb, int nvb) {
  const bool xm = (nvb & 7) == 0 && (g.nM & 7) == 0;
  const int xcd = vb & 7;
  const int mPer = xm ? (g.nM >> 3) : g.nM;
  const int PM = (mPer % 9 == 0) ? 9 : ((mPer & 7) == 0 ? 8 : ((mPer % 6) == 0 ? 6 : mPer));
  const int per = PM * g.nN;
  const int local = mPer * g.nN;
  const int start = xm ? (vb >> 3) : vb, step = xm ? (nvb >> 3) : nvb;
  const int mbase = xm ? xcd * mPer : 0;
  for (int q = start; q < local; q += step) {
    const int mg = q / per;
    const int rem = q - mg * per;
    const int tn = rem / PM;
    const int tm = mbase + mg * PM + (rem - tn * PM);
    gemm_tile<EPI, MI>(g, tm, tn, smem);
  }
}
template <int EPI>
DI void gemm_auto(GemmDesc& g, int M, char* smem, int vb, int nvb) {
  if (M == T) { g.nM = T / 192; gemm_phase<EPI, 3>(g, smem, vb, nvb); }
  else { g.nM = M / 128; gemm_phase<EPI, 2>(g, smem, vb, nvb); }
}

DI GemmDesc gemm_simple(const u16* A, int lda, const u16* Bt, int K, int M, int Npad) {
  GemmDesc g;
  g.A0 = A; g.lda0 = lda; g.kstep0 = 64; g.ksplit = 1 << 20; g.A1 = A; g.lda1 = lda;
  g.Bt = Bt; g.K = K; g.nM = M / 128; g.nN = Npad / 128;
  g.o16 = nullptr; g.ldo = 0; g.nreal = 0; g.side = nullptr; g.slo = 0;
  g.xres = nullptr; g.hres = nullptr; g.mod = nullptr; g.gidx = 0; g.coef = 0.f;
  return g;
}

DI void mla_finalize(const P& p, char* smem, int vb, int nvb) {
  const int tid_ = get_tid();
  const int lane = tid_ & 63, wave = tid_ >> 6;
  const u16* z = (const u16*)(p.ws + OFF_REGB);
  u16* Q = (u16*)(p.ws + OFF_QB);
  u16* Kb = (u16*)(p.ws + OFF_KB);
  u16* KV = (u16*)(p.ws + OFF_REGA);
  float* sq = (float*)smem + wave * 1824;
  float* skv = sq + 768;
  float* skr = skv + 1024;
  const int h = lane >> 3, sub = lane & 7;
  const float QSCALE = 0.10206207261596575f * LOG2E;
  float qn[12], kn[12];
#pragma unroll
  for (int j = 0; j < 12; ++j) { qn[j] = p.ev_q_norm[sub + 8 * j]; kn[j] = p.ev_k_norm[sub + 8 * j]; }
  for (int t = vb * 4 + wave; t < T; t += nvb * 4) {
    float f[8];
    {
      uint4 v = *(const uint4*)(Q + (size_t)t * 768 + lane * 8);
      unpack8(v, f);
#pragma unroll
      for (int j = 0; j < 8; ++j) sq[lane * 8 + j] = f[j];
      if (lane < 32) {
        v = *(const uint4*)(Q + (size_t)t * 768 + (lane + 64) * 8);
        unpack8(v, f);
#pragma unroll
        for (int j = 0; j < 8; ++j) sq[(lane + 64) * 8 + j] = f[j];
      }
    }
    uint4 kv0 = *(const uint4*)(KV + (size_t)t * 1024 + lane * 8);
    uint4 kv1 = *(const uint4*)(KV + (size_t)t * 1024 + (lane + 64) * 8);
    unpack8(kv0, f);
#pragma unroll
    for (int j = 0; j < 8; ++j) skv[lane * 8 + j] = f[j];
    unpack8(kv1, f);
#pragma unroll
    for (int j = 0; j < 8; ++j) skv[(lane + 64) * 8 + j] = f[j];
    if (lane < 32) skr[lane] = bf2f(z[(size_t)t * EVEN_IN + 640 + lane]);
    float ssq = 0.f, sskv = 0.f;
    if (lane < 48) {
      uint4 v = *(const uint4*)(z + (size_t)t * EVEN_IN + lane * 8);
      unpack8(v, f);
#pragma unroll
      for (int j = 0; j < 8; ++j) ssq += f[j] * f[j];
    }
    if (lane < 32) {
      uint4 v = *(const uint4*)(z + (size_t)t * EVEN_IN + 384 + lane * 8);
      unpack8(v, f);
#pragma unroll
      for (int j = 0; j < 8; ++j) sskv += f[j] * f[j];
    }
    ssq = wave_sum(ssq);
    sskv = wave_sum(sskv);
    const float rq = rsqrtf(ssq * (1.f / 384.f) + EPS), rkv = rsqrtf(sskv * (1.f / 256.f) + EPS);
    const bool lat = t < LAT;
    const int pos = t & 2047;
    float cs = 1.f, sn = 0.f;
    if (lat) {
      const int fi = lane & 7;
      const float inv = exp2f(-(float)fi * (13.287712379549449f / 8.f));
      const float pc = (lane & 8) ? (float)(pos & 63) : (float)(pos >> 6);
      float rev = pc * inv * 0.15915494309189535f;
      rev -= floorf(rev);
      cs = __builtin_amdgcn_cosf(rev);
      sn = __builtin_amdgcn_sinf(rev);
    }
    const float c0 = __shfl(cs, sub), s0 = __shfl(sn, sub), c1 = __shfl(cs, sub + 8), s1 = __shfl(sn, sub + 8);
    wave_lds_sync();
    float y[12];
    float ss = 0.f;
#pragma unroll
    for (int j = 0; j < 12; ++j) { y[j] = sq[h * 96 + sub + 8 * j] * rq; ss += y[j] * y[j]; }
    ss += __shfl_xor(ss, 1); ss += __shfl_xor(ss, 2); ss += __shfl_xor(ss, 4);
    float rms = rsqrtf(ss * (1.f / 96.f) + EPS);
#pragma unroll
    for (int j = 0; j < 12; ++j) y[j] *= rms * qn[j];
    if (lat) {
      const float a8 = y[8] * c0 - y[10] * s0, a10 = y[8] * s0 + y[10] * c0;
      const float a9 = y[9] * c1 - y[11] * s1, a11 = y[9] * s1 + y[11] * c1;
      y[8] = a8; y[10] = a10; y[9] = a9; y[11] = a11;
    }
    float kk[12];
    float ssk = 0.f;
#pragma unroll
    for (int j = 0; j < 12; ++j) {
      kk[j] = j < 8 ? skv[h * 128 + sub + 8 * j] * rkv : skr[sub + 8 * j - 64];
      ssk += kk[j] * kk[j];
    }
    ssk += __shfl_xor(ssk, 1); ssk += __shfl_xor(ssk, 2); ssk += __shfl_xor(ssk, 4);
    rms = rsqrtf(ssk * (1.f / 96.f) + EPS);
#pragma unroll
    for (int j = 0; j < 12; ++j) kk[j] *= rms * kn[j];
    if (lat) {
      const float a8 = kk[8] * c0 - kk[10] * s0, a10 = kk[8] * s0 + kk[10] * c0;
      const float a9 = kk[9] * c1 - kk[11] * s1, a11 = kk[9] * s1 + kk[11] * c1;
      kk[8] = a8; kk[10] = a10; kk[9] = a9; kk[11] = a11;
    }
    wave_lds_sync();
#pragma unroll
    for (int j = 0; j < 12; ++j) sq[h * 96 + sub + 8 * j] = y[j] * QSCALE;
    wave_lds_sync();
    {
      *(uint4*)(Q + (size_t)t * 768 + lane * 8) = pack8(sq + lane * 8);
      if (lane < 32) *(uint4*)(Q + (size_t)t * 768 + (lane + 64) * 8) = pack8(sq + (lane + 64) * 8);
    }
    wave_lds_sync();
#pragma unroll
    for (int j = 0; j < 12; ++j) sq[h * 96 + sub + 8 * j] = kk[j];
    wave_lds_sync();
    {
      *(uint4*)(Kb + (size_t)t * 768 + lane * 8) = pack8(sq + lane * 8);
      if (lane < 32) *(uint4*)(Kb + (size_t)t * 768 + (lane + 64) * 8) = pack8(sq + (lane + 64) * 8);
    }
    if (lane & 8) {
      unpack8(kv0, f);
#pragma unroll
      for (int j = 0; j < 8; ++j) f[j] *= rkv;
      *(uint4*)(KV + (size_t)t * 1024 + lane * 8) = pack8(f);
      unpack8(kv1, f);
#pragma unroll
      for (int j = 0; j < 8; ++j) f[j] *= rkv;
      *(uint4*)(KV + (size_t)t * 1024 + (lane + 64) * 8) = pack8(f);
    }
    wave_lds_sync();
  }
}

DI void swa_finalize(const P& p, char* smem, int vb, int nvb) {
  const int tid_ = get_tid();
  const int lane = tid_ & 63, wave = tid_ >> 6;
  const u16* z = (const u16*)(p.ws + OFF_REGB);
  u16* Q = (u16*)(p.ws + OFF_QB);
  u16* Kb = (u16*)(p.ws + OFF_KB);
  const int sub = lane & 7;
  const float SSCALE = 0.125f * LOG2E;
  float qn[8], kn[8];
#pragma unroll
  for (int j = 0; j < 8; ++j) { qn[j] = p.od_q_norm[sub * 8 + j]; kn[j] = p.od_k_norm[sub * 8 + j]; }
  const float* side = (const float*)(p.ws + OFF_SIDE);
  float* alpha0 = (float*)(p.ws + OFF_KB + (size_t)T * 128 * 2);
  float* alpha1 = (float*)(p.ws + OFF_REGA + (size_t)LAT * 512 * 2);
  float* w2s = (float*)smem;
  float* gbs = w2s + 8192;
  float* sds = gbs + 512 + wave * 32;
  __syncthreads();
  for (int i = tid_; i < 8192; i += NTHR) w2s[i] = p.od_w2[i];
  for (int i = tid_; i < 512; i += NTHR) gbs[i] = p.od_gb[i];
  __syncthreads();
  for (int t = vb * 4 + wave; t < T; t += nvb * 4) {
    if (lane < 32) sds[lane] = side[(size_t)t * 32 + lane];
    wave_lds_sync();
#pragma unroll
    for (int dr = 0; dr < 2; ++dr) {
      f32x4v lg = *(const f32x4v*)(gbs + dr * 256 + lane * 4);
#pragma unroll
      for (int r4 = 0; r4 < 4; ++r4) {
        const f32x4v zg = *(const f32x4v*)(sds + dr * 16 + r4 * 4);
        lg += *(const f32x4v*)(w2s + (dr * 16 + r4 * 4 + 0) * 256 + lane * 4) * zg.x;
        lg += *(const f32x4v*)(w2s + (dr * 16 + r4 * 4 + 1) * 256 + lane * 4) * zg.y;
        lg += *(const f32x4v*)(w2s + (dr * 16 + r4 * 4 + 2) * 256 + lane * 4) * zg.z;
        lg += *(const f32x4v*)(w2s + (dr * 16 + r4 * 4 + 3) * 256 + lane * 4) * zg.w;
      }
      f32x4v al;
      al.x = __expf((fminf(lg.x, 0.f) - __logf(1.f + __expf(-fabsf(lg.x)))) * (1.f / 16.f));
      al.y = __expf((fminf(lg.y, 0.f) - __logf(1.f + __expf(-fabsf(lg.y)))) * (1.f / 16.f));
      al.z = __expf((fminf(lg.z, 0.f) - __logf(1.f + __expf(-fabsf(lg.z)))) * (1.f / 16.f));
      al.w = __expf((fminf(lg.w, 0.f) - __logf(1.f + __expf(-fabsf(lg.w)))) * (1.f / 16.f));
      *(f32x4v*)((dr == 0 ? alpha0 : alpha1) + (size_t)t * 256 + lane * 4) = al;
    }
    wave_lds_sync();
    const bool lat = t < LAT;
    const int pos = t & 2047;
    float cs = 1.f, sn = 0.f;
    if (lat) {
      const int fi = lane & 15;
      const float inv = exp2f(-(float)fi * (13.287712379549449f / 16.f));
      const float pc = (lane & 16) ? (float)(pos & 63) : (float)(pos >> 6);
      float rev = pc * inv * 0.15915494309189535f;
      rev -= floorf(rev);
      cs = __builtin_amdgcn_cosf(rev);
      sn = __builtin_amdgcn_sinf(rev);
    }
    float cj[8], sj[8];
#pragma unroll
    for (int j = 0; j < 8; ++j) { cj[j] = __shfl(cs, (sub & 3) * 8 + j); sj[j] = __shfl(sn, (sub & 3) * 8 + j); }
    float f[8];
    if (lat) {
      uint4 v = *(const uint4*)(z + (size_t)t * ODD_IN + 1568 + lane * 8);
      unpack8(v, f);
      float ss = 0.f;
#pragma unroll
      for (int j = 0; j < 8; ++j) ss += f[j] * f[j];
      ss += __shfl_xor(ss, 1); ss += __shfl_xor(ss, 2); ss += __shfl_xor(ss, 4);
      const float rms = rsqrtf(ss * (1.f / 64.f) + EPS);
#pragma unroll
      for (int j = 0; j < 8; ++j) {
        const float yv = f[j] * rms * qn[j];
        const float pv = __shfl_xor(yv, 4);
        const float o = (sub < 4) ? (yv * cj[j] - pv * sj[j]) : (pv * sj[j] + yv * cj[j]);
        f[j] = o * SSCALE;
      }
      *(uint4*)(Q + (size_t)t * 512 + lane * 8) = pack8(f);
    }
    {
      const int l16 = lane & 15;
      uint4 v = *(const uint4*)(z + (size_t)t * ODD_IN + 2080 + l16 * 8);
      unpack8(v, f);
      float ss = 0.f;
#pragma unroll
      for (int j = 0; j < 8; ++j) ss += f[j] * f[j];
      ss += __shfl_xor(ss, 1); ss += __shfl_xor(ss, 2); ss += __shfl_xor(ss, 4);
      const float rms = rsqrtf(ss * (1.f / 64.f) + EPS);
#pragma unroll
      for (int j = 0; j < 8; ++j) {
        const float yv = f[j] * rms * kn[j];
        const float pv = __shfl_xor(yv, 4);
        float o = yv;
        if (lat) o = (sub < 4) ? (yv * cj[j] - pv * sj[j]) : (pv * sj[j] + yv * cj[j]);
        f[j] = o;
      }
      if (lane < 16) *(uint4*)(Kb + (size_t)t * 128 + lane * 8) = pack8(f);
    }
  }
}

template <int DQK, bool SWA>
DI void attn_item(const u16* __restrict__ Q, int ldq, int qoff, const u16* __restrict__ Kp, int ldk, int koff,
                  const u16* __restrict__ Vp, int ldv, int voff, int qrow0, int qpos0, int crow0, int lrow0, int kt_lo,
                  int kt_hi, float sink2, u16* __restrict__ O, int ldo, int ooff, char* smem) {
  constexpr int KSTR = DQK + 8, VSTR = 72, CPR = DQK / 8, NKC = 64 * CPR / 256, NKS = DQK / 16;
  u16* Ks = (u16*)smem;
  u16* Vt = Ks + 2 * 64 * KSTR;
  const int tid = get_tid(), lane = tid & 63, wave = tid >> 6, r = lane & 31, hh = lane >> 5;
  const int nt = 4 + (kt_hi - kt_lo);
  bf16x8 bq[NKS];
  {
    const u16* qp = Q + (size_t)(qrow0 + wave * 32 + r) * ldq + qoff + hh * 8;
#pragma unroll
    for (int ks = 0; ks < NKS; ++ks) bq[ks] = *(const bf16x8*)(qp + ks * 16);
  }
  u32x4 rk[NKC], rv[2];
#define A_LOADG(IT)                                                                                   \
  {                                                                                                   \
    const int i_ = (IT);                                                                              \
    const int base_ = i_ < 4 ? crow0 + i_ * 64 : lrow0 + (kt_lo + i_ - 4) * 64;                       \
    _Pragma("unroll") for (int j = 0; j < NKC; ++j) {                                                 \
      const int c = tid + 256 * j, row = c / CPR, kc = c % CPR;                                       \
      rk[j] = *(const u32x4*)(Kp + (size_t)(base_ + row) * ldk + koff + kc * 8);                      \
    }                                                                                                 \
    _Pragma("unroll") for (int j = 0; j < 2; ++j) {                                                   \
      const int c = tid + 256 * j, row = c >> 3, dc = c & 7;                                          \
      rv[j] = *(const u32x4*)(Vp + (size_t)(base_ + row) * ldv + voff + dc * 8);                      \
    }                                                                                                 \
  }
#define A_STORES(BUF)                                                                                 \
  {                                                                                                   \
    const int buf_ = (BUF);                                                                           \
    _Pragma("unroll") for (int j = 0; j < NKC; ++j) {                                                 \
      const int c = tid + 256 * j, row = c / CPR, kc = c % CPR;                                       \
      *(u32x4*)(Ks + buf_ * 64 * KSTR + row * KSTR + kc * 8) = rk[j];                                 \
    }                                                                                                 \
    _Pragma("unroll") for (int j = 0; j < 2; ++j) {                                                   \
      const int c = tid + 256 * j, key = c >> 3, dc = c & 7;                                          \
      u16* vb = Vt + buf_ * 64 * VSTR + (dc * 8) * VSTR + key;                                        \
      const unsigned w0 = rv[j].x, w1 = rv[j].y, w2 = rv[j].z, w3 = rv[j].w;                          \
      vb[0 * VSTR] = (u16)(w0 & 0xffff); vb[1 * VSTR] = (u16)(w0 >> 16);                              \
      vb[2 * VSTR] = (u16)(w1 & 0xffff); vb[3 * VSTR] = (u16)(w1 >> 16);                              \
      vb[4 * VSTR] = (u16)(w2 & 0xffff); vb[5 * VSTR] = (u16)(w2 >> 16);                              \
      vb[6 * VSTR] = (u16)(w3 & 0xffff); vb[7 * VSTR] = (u16)(w3 >> 16);                              \
    }                                                                                                 \
  }
  f32x16 o[2];
#pragma unroll
  for (int a = 0; a < 2; ++a)
#pragma unroll
    for (int i = 0; i < 16; ++i) o[a][i] = 0.f;
  float m = -INFINITY, lsum = 0.f;
  A_LOADG(0);
  A_STORES(0);
  __syncthreads();
  for (int it = 0; it < nt; ++it) {
    const int buf = it & 1;
    if (it + 1 < nt) A_LOADG(it + 1);
    f32x16 s[2];
#pragma unroll
    for (int mt = 0; mt < 2; ++mt) {
#pragma unroll
      for (int i = 0; i < 16; ++i) s[mt][i] = 0.f;
      const u16* kb = Ks + buf * 64 * KSTR + (mt * 32 + r) * KSTR + hh * 8;
#pragma unroll
      for (int ks = 0; ks < NKS; ++ks) {
        const bf16x8 a = *(const bf16x8*)(kb + ks * 16);
        s[mt] = MFMA(a, bq[ks], s[mt]);
      }
    }
    if (SWA && it >= 4) {
      const int kpos0 = (kt_lo + it - 4) * 64;
      const int qpos = qpos0 + wave * 32 + r;
#pragma unroll
      for (int mt = 0; mt < 2; ++mt)
#pragma unroll
        for (int i = 0; i < 16; ++i) {
          const int kpos = kpos0 + mt * 32 + (i & 3) + 8 * (i >> 2) + 4 * hh;
          const int dlt = kpos - qpos;
          if (dlt > 128 || dlt < -128) s[mt][i] = -INFINITY;
        }
    }
    float mx = -INFINITY;
#pragma unroll
    for (int mt = 0; mt < 2; ++mt)
#pragma unroll
      for (int i = 0; i < 16; ++i) mx = fmaxf(mx, s[mt][i]);
    mx = fmaxf(mx, __shfl_xor(mx, 32));
    const float mnew = fmaxf(m, mx);
    const bool chg = __ballot(mnew > m) != 0ull;
    const float alpha = chg ? __builtin_amdgcn_exp2f(m - mnew) : 1.f;
    m = mnew;
    float psum = 0.f;
#pragma unroll
    for (int mt = 0; mt < 2; ++mt)
#pragma unroll
      for (int i = 0; i < 16; ++i) {
        const float pv = __builtin_amdgcn_exp2f(s[mt][i] - mnew);
        s[mt][i] = pv;
        psum += pv;
      }
    if (chg) {
      lsum *= alpha;
#pragma unroll
      for (int a = 0; a < 2; ++a)
#pragma unroll
        for (int i = 0; i < 16; ++i) o[a][i] *= alpha;
    }
    lsum += psum;
#pragma unroll
    for (int mt = 0; mt < 2; ++mt)
#pragma unroll
      for (int sx = 0; sx < 2; ++sx) {
        uint4 pu;
        pu.x = pack2(s[mt][8 * sx + 0], s[mt][8 * sx + 1]);
        pu.y = pack2(s[mt][8 * sx + 2], s[mt][8 * sx + 3]);
        pu.z = pack2(s[mt][8 * sx + 4], s[mt][8 * sx + 5]);
        pu.w = pack2(s[mt][8 * sx + 6], s[mt][8 * sx + 7]);
        const bf16x8 pfv = __builtin_bit_cast(bf16x8, pu);
#pragma unroll
        for (int dt = 0; dt < 2; ++dt) {
          const u16* vp = Vt + buf * 64 * VSTR + (dt * 32 + r) * VSTR + mt * 32 + 16 * sx + 4 * hh;
          const uint2 v0 = *(const uint2*)(vp);
          const uint2 v1 = *(const uint2*)(vp + 8);
          const uint4 vu = make_uint4(v0.x, v0.y, v1.x, v1.y);
          o[dt] = MFMA(__builtin_bit_cast(bf16x8, vu), pfv, o[dt]);
        }
      }
    if (it + 1 < nt) A_STORES(buf ^ 1);
    __syncthreads();
  }
  float l = lsum + __shfl_xor(lsum, 32);
  if (SWA) l += __builtin_amdgcn_exp2f(sink2 - m);
  const float inv = 1.f / l;
  u16* op = O + (size_t)(qrow0 + wave * 32 + r) * ldo + ooff;
#pragma unroll
  for (int dt = 0; dt < 2; ++dt)
#pragma unroll
    for (int g4 = 0; g4 < 4; ++g4) {
      uint2 w;
      w.x = pack2(o[dt][4 * g4 + 0] * inv, o[dt][4 * g4 + 1] * inv);
      w.y = pack2(o[dt][4 * g4 + 2] * inv, o[dt][4 * g4 + 3] * inv);
      *(uint2*)(op + dt * 32 + 8 * g4 + 4 * hh) = w;
    }
}

DI void gdn_chain(const P& p, int cid, char* smem) {
  const int eb = cid & 1, chn = cid >> 1;
  const int dir = chn >> 6, b = (chn >> 3) & 7, h = chn & 7;
  float* qs = (float*)smem;
  float* ks = qs + 4096;
  float* vs = ks + 4096;
  float* ob = vs + 2048;
  float* ps = ob + 2048;
  float* cw = ps + 256;
  const int tid = get_tid(), lane = tid & 63, wave = tid >> 6;
  const u16* z = (const u16*)(p.ws + OFF_REGB);
  const float* side = (const float*)(p.ws + OFF_SIDE);
  u16* od = (u16*)(p.ws + OFF_ODIR) + (size_t)dir * T * 512;
  __syncthreads();
  for (int i = tid; i < 800; i += NTHR) {
    const int j = i / 160, cc = i % 160;
    const int chi = cc < 64 ? h * 64 + cc : (cc < 128 ? 512 + h * 64 + (cc - 64) : 1024 + h * 64 + eb * 32 + (cc - 128));
    cw[i] = p.ev_conv[j * 1536 + chi];
  }
  const float Aexp = __expf(p.ev_a_log[dir * 8 + h]);
  const float dtb = p.ev_dt_bias[dir * 8 + h];
  __builtin_amdgcn_s_setprio(3);
  f32x2 S[4];
#pragma unroll
  for (int i = 0; i < 4; ++i) S[i] = (f32x2){0.f, 0.f};
  const int dl = lane & 7, ec = wave * 8 + (lane >> 3);
  const int pp = tid >> 2, qd = tid & 3;
  __syncthreads();
  for (int seg = 0; seg < 2; ++seg) {
    const int len = seg == 0 ? CTXL : SEQ;
    const int base = seg == 0 ? LAT + b * CTXL : b * SEQ;
    for (int c = 0; c < len / 64; ++c) {
      {
        const int pos = c * 64 + pp;
        const int tau = dir ? len - 1 - pos : pos;
        float aq[16], ak[16], av[8];
#pragma unroll
        for (int i = 0; i < 16; ++i) { aq[i] = 0.f; ak[i] = 0.f; }
#pragma unroll
        for (int i = 0; i < 8; ++i) av[i] = 0.f;
#pragma unroll
        for (int j = 0; j < 5; ++j) {
          const int tt = tau + j - 2;
          if (tt >= 0 && tt < len) {
            const u16* zr = z + (size_t)(base + tt) * EVEN_IN + h * 64;
            float f[16];
            unpack8(*(const uint4*)(zr + 672 + qd * 16), f); unpack8(*(const uint4*)(zr + 672 + qd * 16 + 8), f + 8);
#pragma unroll
            for (int i = 0; i < 16; ++i) aq[i] += cw[j * 160 + qd * 16 + i] * f[i];
            unpack8(*(const uint4*)(zr + 1184 + qd * 16), f); unpack8(*(const uint4*)(zr + 1184 + qd * 16 + 8), f + 8);
#pragma unroll
            for (int i = 0; i < 16; ++i) ak[i] += cw[j * 160 + 64 + qd * 16 + i] * f[i];
            unpack8(*(const uint4*)(zr + 1696 + eb * 32 + qd * 8), f);
#pragma unroll
            for (int i = 0; i < 8; ++i) av[i] += cw[j * 160 + 128 + qd * 8 + i] * f[i];
          }
        }
        float sq2 = 0.f, sk2 = 0.f;
#pragma unroll
        for (int i = 0; i < 16; ++i) {
          aq[i] = silu_f(aq[i]); ak[i] = silu_f(ak[i]);
          sq2 += aq[i] * aq[i]; sk2 += ak[i] * ak[i];
        }
        sq2 = quad_sum(sq2);
        sk2 = quad_sum(sk2);
        const float rq = rsqrtf(sq2 + EPS) * 0.125f, rk = rsqrtf(sk2 + EPS);
#pragma unroll
        for (int i = 0; i < 16; ++i) { aq[i] *= rq; ak[i] *= rk; }
#pragma unroll
        for (int i = 0; i < 4; ++i) {
          *(float4*)(qs + pp * 64 + qd * 16 + i * 4) = make_float4(aq[4 * i], aq[4 * i + 1], aq[4 * i + 2], aq[4 * i + 3]);
          *(float4*)(ks + pp * 64 + qd * 16 + i * 4) = make_float4(ak[4 * i], ak[4 * i + 1], ak[4 * i + 2], ak[4 * i + 3]);
        }
        *(float4*)(vs + pp * 32 + qd * 8) = make_float4(silu_f(av[0]), silu_f(av[1]), silu_f(av[2]), silu_f(av[3]));
        *(float4*)(vs + pp * 32 + qd * 8 + 4) = make_float4(silu_f(av[4]), silu_f(av[5]), silu_f(av[6]), silu_f(av[7]));
        float gsame = 0.f, kk = 0.f, g21 = 0.f;
#pragma unroll
        for (int i = 0; i < 16; ++i) {
          const float kp = __builtin_bit_cast(float, __builtin_amdgcn_mov_dpp(__builtin_bit_cast(int, ak[i]), 0x114, 0xF, 0xF, true));
          gsame += aq[i] * ak[i];
          kk += kp * ak[i];
          g21 += aq[i] * kp;
        }
        gsame = quad_sum(gsame);
        kk = quad_sum(kk);
        g21 = quad_sum(g21);
        if (qd == 0) {
          const float za = side[(size_t)(base + tau) * 32 + dir * 8 + h];
          const float zb = side[(size_t)(base + tau) * 32 + 16 + dir * 8 + h];
          const float av_ = __expf(-Aexp * softplus_f(za + dtb));
          const float bv_ = sigmoid_f(zb);
          float* pr = ps + (pp >> 1) * 8;
          if (pp & 1) { pr[2] = av_; pr[3] = bv_; pr[4] = kk; pr[6] = g21; pr[7] = gsame; }
          else { pr[0] = av_; pr[1] = bv_; pr[5] = gsame; }
        }
      }
      __syncthreads();
#define GDN_LOAD2(M, X)                                                                     \
  X##k1a = *(const f32x4v*)(ks + (2 * (M)) * 64 + dl * 8); X##k1b = *(const f32x4v*)(ks + (2 * (M)) * 64 + dl * 8 + 4);         \
  X##k2a = *(const f32x4v*)(ks + (2 * (M) + 1) * 64 + dl * 8); X##k2b = *(const f32x4v*)(ks + (2 * (M) + 1) * 64 + dl * 8 + 4); \
  X##q1a = *(const f32x4v*)(qs + (2 * (M)) * 64 + dl * 8); X##q1b = *(const f32x4v*)(qs + (2 * (M)) * 64 + dl * 8 + 4);         \
  X##q2a = *(const f32x4v*)(qs + (2 * (M) + 1) * 64 + dl * 8); X##q2b = *(const f32x4v*)(qs + (2 * (M) + 1) * 64 + dl * 8 + 4); \
  X##v1 = vs[(2 * (M)) * 32 + ec]; X##v2 = vs[(2 * (M) + 1) * 32 + ec];                      \
  X##s0 = *(const f32x4v*)(ps + (M) * 8); X##s1 = *(const f32x4v*)(ps + (M) * 8 + 4);        \
  __builtin_amdgcn_sched_barrier(0);
#define GDN_DOT(VA, VB, OUT)                                                                \
  {                                                                                         \
    f32x2 d_ = VA.xy * S[0] + VA.zw * S[1];                                                 \
    d_ += VB.xy * S[2] + VB.zw * S[3];                                                      \
    OUT = d_.x + d_.y;                                                                      \
  }
#define GDN_STEP2(U, X)                                                                     \
  {                                                                                         \
    const float a1 = X##s0.x, b1 = X##s0.y, a2 = X##s0.z, b2 = X##s0.w;                     \
    const float kk = X##s1.x, g11 = X##s1.y, g21 = X##s1.z, g22 = X##s1.w;                  \
    float p1, p2, r1, r2;                                                                   \
    GDN_DOT(X##k1a, X##k1b, p1) GDN_DOT(X##k2a, X##k2b, p2)                                 \
    GDN_DOT(X##q1a, X##q1b, r1) GDN_DOT(X##q2a, X##q2b, r2)                                 \
    p1 = row8_sum(p1); p2 = row8_sum(p2); r1 = row8_sum(r1); r2 = row8_sum(r2);             \
    const float c1 = b1 * (X##v1 - a1 * p1);                                                \
    const float o1 = a1 * r1 + g11 * c1;                                                    \
    const float c2 = b2 * (X##v2 - a2 * (a1 * p2 + kk * c1));                               \
    const float o2 = a2 * (a1 * r2 + g21 * c1) + g22 * c2;                                  \
    const float a21 = a2 * a1, w1 = a2 * c1;                                                \
    const f32x2 A2 = (f32x2){a21, a21}, W1 = (f32x2){w1, w1}, C2 = (f32x2){c2, c2};          \
    S[0] = A2 * S[0] + X##k1a.xy * W1 + X##k2a.xy * C2;                                     \
    S[1] = A2 * S[1] + X##k1a.zw * W1 + X##k2a.zw * C2;                                     \
    S[2] = A2 * S[2] + X##k1b.xy * W1 + X##k2b.xy * C2;                                     \
    S[3] = A2 * S[3] + X##k1b.zw * W1 + X##k2b.zw * C2;                                     \
    myo = (dl == 2 * (U)) ? o1 : myo;                                                       \
    myo = (dl == 2 * (U) + 1) ? o2 : myo;                                                   \
    __builtin_amdgcn_sched_barrier(0);                                                      \
  }
      f32x4v Ak1a, Ak1b, Ak2a, Ak2b, Aq1a, Aq1b, Aq2a, Aq2b, As0, As1;
      f32x4v Bk1a, Bk1b, Bk2a, Bk2b, Bq1a, Bq1b, Bq2a, Bq2b, Bs0, Bs1;
      float Av1, Av2, Bv1, Bv2;
      GDN_LOAD2(0, A)
      for (int t0 = 0; t0 < 64; t0 += 8) {
        float myo = 0.f;
        const int m0 = t0 >> 1;
        GDN_LOAD2(m0 + 1, B) GDN_STEP2(0, A)
        GDN_LOAD2(m0 + 2, A) GDN_STEP2(1, B)
        GDN_LOAD2(m0 + 3, B) GDN_STEP2(2, A)
        GDN_LOAD2(m0 + 4, A) GDN_STEP2(3, B)
        const int pos = c * 64 + t0 + dl;
        const int tau = dir ? len - 1 - pos : pos;
        od[(size_t)(base + tau) * 512 + h * 64 + eb * 32 + ec] = f2bf(myo);
      }
      __syncthreads();
    }
  }
  __builtin_amdgcn_s_setprio(0);
}

DI void gla_chain(const P& p, int cid, char* smem) {
  const int e4 = cid & 3, chn = cid >> 2;
  const int dir = chn >> 5, b = (chn >> 2) & 7, h = chn & 3;
  float* qs = (float*)smem;
  float* ks = qs + 4096;
  float* as = ks + 4096;
  float* vs = as + 4096;
  float* ob = vs + 2048;
  const int tid = get_tid(), lane = tid & 63, wave = tid >> 6;
  const u16* z = (const u16*)(p.ws + OFF_REGB);
  const float* alpha = dir == 0 ? (const float*)(p.ws + OFF_KB + (size_t)T * 128 * 2)
                                : (const float*)(p.ws + OFF_REGA + (size_t)LAT * 512 * 2);
  u16* od = (u16*)(p.ws + OFF_ODIR) + (size_t)dir * T * 512;
  __builtin_amdgcn_s_setprio(3);
  f32x2 S[4];
#pragma unroll
  for (int i = 0; i < 4; ++i) S[i] = (f32x2){0.f, 0.f};
  const int dl = lane & 7, ec = wave * 8 + (lane >> 3);
  const int pp = tid >> 2, qd = tid & 3;
  __syncthreads();
  for (int seg = 0; seg < 2; ++seg) {
    const int len = seg == 0 ? CTXL : SEQ;
    const int base = seg == 0 ? LAT + b * CTXL : b * SEQ;
    for (int c = 0; c < len / 64; ++c) {
      {
        const int pos = c * 64 + pp;
        const int tau = dir ? len - 1 - pos : pos;
        const u16* zr = z + (size_t)(base + tau) * ODD_IN;
        float f[16];
        unpack8(*(const uint4*)(zr + h * 64 + qd * 16), f); unpack8(*(const uint4*)(zr + h * 64 + qd * 16 + 8), f + 8);
#pragma unroll
        for (int i = 0; i < 4; ++i)
          *(float4*)(qs + pp * 64 + qd * 16 + i * 4) =
              make_float4(f[4 * i] * 0.125f, f[4 * i + 1] * 0.125f, f[4 * i + 2] * 0.125f, f[4 * i + 3] * 0.125f);
        unpack8(*(const uint4*)(zr + 256 + h * 64 + qd * 16), f); unpack8(*(const uint4*)(zr + 256 + h * 64 + qd * 16 + 8), f + 8);
#pragma unroll
        for (int i = 0; i < 4; ++i)
          *(float4*)(ks + pp * 64 + qd * 16 + i * 4) = make_float4(f[4 * i], f[4 * i + 1], f[4 * i + 2], f[4 * i + 3]);
        const float* ar = alpha + (size_t)(base + tau) * 256 + h * 64 + qd * 16;
#pragma unroll
        for (int i = 0; i < 4; ++i) *(float4*)(as + pp * 64 + qd * 16 + i * 4) = *(const float4*)(ar + i * 4);
        unpack8(*(const uint4*)(zr + 512 + h * 128 + e4 * 32 + qd * 8), f);
        *(float4*)(vs + pp * 32 + qd * 8) = make_float4(f[0], f[1], f[2], f[3]);
        *(float4*)(vs + pp * 32 + qd * 8 + 4) = make_float4(f[4], f[5], f[6], f[7]);
      }
      __syncthreads();
      if (seg == 0) {
#pragma unroll 4
        for (int t = 0; t < 64; ++t) {
          const f32x4v ka = *(const f32x4v*)(ks + t * 64 + dl * 8), kb = *(const f32x4v*)(ks + t * 64 + dl * 8 + 4);
          const f32x4v aa = *(const f32x4v*)(as + t * 64 + dl * 8), ab = *(const f32x4v*)(as + t * 64 + dl * 8 + 4);
          const float v = vs[t * 32 + ec];
          const f32x2 v2 = (f32x2){v, v};
          S[0] = aa.xy * S[0] + ka.xy * v2; S[1] = aa.zw * S[1] + ka.zw * v2;
          S[2] = ab.xy * S[2] + kb.xy * v2; S[3] = ab.zw * S[3] + kb.zw * v2;
        }
        __syncthreads();
      } else {
#define GLA_LOAD(TT, X)                                                                     \
  X##ka = *(const f32x4v*)(ks + (TT) * 64 + dl * 8); X##kb = *(const f32x4v*)(ks + (TT) * 64 + dl * 8 + 4); \
  X##qa = *(const f32x4v*)(qs + (TT) * 64 + dl * 8); X##qb = *(const f32x4v*)(qs + (TT) * 64 + dl * 8 + 4); \
  X##aa = *(const f32x4v*)(as + (TT) * 64 + dl * 8); X##ab = *(const f32x4v*)(as + (TT) * 64 + dl * 8 + 4); \
  X##v = vs[(TT) * 32 + ec];                                                                \
  __builtin_amdgcn_sched_barrier(0);
#define GLA_STEP(U, X)                                                                      \
  {                                                                                         \
    const f32x2 v2 = (f32x2){X##v, X##v};                                                   \
    S[0] = X##aa.xy * S[0] + X##ka.xy * v2; S[1] = X##aa.zw * S[1] + X##ka.zw * v2;         \
    S[2] = X##ab.xy * S[2] + X##kb.xy * v2; S[3] = X##ab.zw * S[3] + X##kb.zw * v2;         \
    f32x2 orr = X##qa.xy * S[0] + X##qa.zw * S[1];                                          \
    orr += X##qb.xy * S[2] + X##qb.zw * S[3];                                               \
    const float ov = row8_sum(orr.x + orr.y);                                               \
    myo = (dl == (U)) ? ov : myo;                                                           \
    __builtin_amdgcn_sched_barrier(0);                                                      \
  }
        f32x4v Aka, Akb, Aqa, Aqb, Aaa, Aab, Bka, Bkb, Bqa, Bqb, Baa, Bab;
        float Av, Bv;
        GLA_LOAD(0, A)
        for (int t0 = 0; t0 < 64; t0 += 8) {
          float myo = 0.f;
          GLA_LOAD(t0 + 1, B) GLA_STEP(0, A)
          GLA_LOAD(t0 + 2, A) GLA_STEP(1, B)
          GLA_LOAD(t0 + 3, B) GLA_STEP(2, A)
          GLA_LOAD(t0 + 4, A) GLA_STEP(3, B)
          GLA_LOAD(t0 + 5, B) GLA_STEP(4, A)
          GLA_LOAD(t0 + 6, A) GLA_STEP(5, B)
          GLA_LOAD(t0 + 7, B) GLA_STEP(6, A)
          GLA_LOAD(t0 + 8, A) GLA_STEP(7, B)
          const int pos = c * 64 + t0 + dl;
          const int tau = dir ? len - 1 - pos : pos;
          od[(size_t)(base + tau) * 512 + h * 128 + e4 * 32 + ec] = f2bf(myo);
        }
        __syncthreads();
      }
    }
  }
  __builtin_amdgcn_s_setprio(0);
}

DI void gla_chain_mfma(const P& p, int cid, char* smem) {
  const int eh = cid & 1, chn = cid >> 1;
  const int dir = chn >> 5, b = (chn >> 2) & 7, h = chn & 3;
  u16* QD = (u16*)smem;
  u16* KI = QD + 64 * 72;
  u16* KDT = KI + 64 * 72;
  u16* VT = KDT + 64 * 72;
  u16* ST = VT + 64 * 72;
  float* BC = (float*)(ST + 64 * 72);
  const int tid = get_tid(), lane = tid & 63, wave = tid >> 6, r = lane & 31, hh = lane >> 5;
  const int et = wave >> 1, it = wave & 1;
  const int pp = tid >> 2, q4 = tid & 3;
  const u16* z = (const u16*)(p.ws + OFF_REGB);
  const float* alpha = dir == 0 ? (const float*)(p.ws + OFF_KB + (size_t)T * 128 * 2)
                                : (const float*)(p.ws + OFF_REGA + (size_t)LAT * 512 * 2);
  u16* od = (u16*)(p.ws + OFF_ODIR) + (size_t)dir * T * 512;
  __syncthreads();
  for (int i = tid; i < 64 * 72 / 2; i += NTHR) ((unsigned*)ST)[i] = 0u;
  f32x16 Sreg;
#pragma unroll
  for (int i = 0; i < 16; ++i) Sreg[i] = 0.f;
  __syncthreads();
  u32x4 rq0, rq1, rk0, rk1, rv0, rv1;
  f32x4v ra0, ra1, ra2, ra3;
#define GLM_RAW(G)                                                                                    \
  {                                                                                                   \
    const int g_ = (G);                                                                               \
    const int sg_ = g_ < 4 ? 0 : 1, c_ = sg_ ? g_ - 4 : g_;                                           \
    const int len_ = sg_ ? SEQ : CTXL, base_ = sg_ ? b * SEQ : LAT + b * CTXL;                        \
    const int pos_ = c_ * 64 + pp;                                                                    \
    const int tau_ = dir ? len_ - 1 - pos_ : pos_;                                                    \
    const u16* zr_ = z + (size_t)(base_ + tau_) * ODD_IN;                                             \
    rq0 = *(const u32x4*)(zr_ + h * 64 + q4 * 16); rq1 = *(const u32x4*)(zr_ + h * 64 + q4 * 16 + 8); \
    rk0 = *(const u32x4*)(zr_ + 256 + h * 64 + q4 * 16); rk1 = *(const u32x4*)(zr_ + 256 + h * 64 + q4 * 16 + 8); \
    rv0 = *(const u32x4*)(zr_ + 512 + h * 128 + eh * 64 + q4 * 16);                                   \
    rv1 = *(const u32x4*)(zr_ + 512 + h * 128 + eh * 64 + q4 * 16 + 8);                               \
    const float* ar_ = alpha + (size_t)(base_ + tau_) * 256 + h * 64 + q4 * 16;                       \
    ra0 = *(const f32x4v*)(ar_); ra1 = *(const f32x4v*)(ar_ + 4); ra2 = *(const f32x4v*)(ar_ + 8); ra3 = *(const f32x4v*)(ar_ + 12); \
  }
  GLM_RAW(0)
  {
    for (int gidx = 0; gidx < 36; ++gidx) {
      const int seg = gidx < 4 ? 0 : 1, c = seg ? gidx - 4 : gidx;
      const int len = seg ? SEQ : CTXL;
      const int base = seg ? b * SEQ : LAT + b * CTXL;
      float qf[16], kf[16];
      {
        unpack8v(rq0, qf); unpack8v(rq1, qf + 8);
        unpack8v(rk0, kf); unpack8v(rk1, kf + 8);
        const f32x4v al[4] = {ra0, ra1, ra2, ra3};
#pragma unroll
        for (int i = 0; i < 4; ++i) {
          BC[pp * 65 + q4 * 16 + i * 4 + 0] = __logf(al[i].x); BC[pp * 65 + q4 * 16 + i * 4 + 1] = __logf(al[i].y);
          BC[pp * 65 + q4 * 16 + i * 4 + 2] = __logf(al[i].z); BC[pp * 65 + q4 * 16 + i * 4 + 3] = __logf(al[i].w);
        }
        const unsigned vw[8] = {rv0.x, rv0.y, rv0.z, rv0.w, rv1.x, rv1.y, rv1.z, rv1.w};
#pragma unroll
        for (int i = 0; i < 8; ++i) {
          VT[(q4 * 16 + 2 * i) * 72 + pp] = (u16)(vw[i] & 0xffffu);
          VT[(q4 * 16 + 2 * i + 1) * 72 + pp] = (u16)(vw[i] >> 16);
        }
        if (gidx + 1 < 36) GLM_RAW(gidx + 1)
      }
      __syncthreads();
      if (tid < 64) {
        float run = 0.f;
#pragma unroll 8
        for (int j = 0; j < 64; ++j) { run += BC[j * 65 + tid]; BC[j * 65 + tid] = run; }
      }
      __syncthreads();
      {
        unsigned wq[8], wk[8];
#pragma unroll
        for (int i = 0; i < 8; ++i) {
          float qv[2], kv2[2];
#pragma unroll
          for (int u = 0; u < 2; ++u) {
            const int d = q4 * 16 + 2 * i + u;
            const float bcv = BC[pp * 65 + d], bl = BC[63 * 65 + d];
            const float e1 = __expf(bcv);
            qv[u] = qf[2 * i + u] * 0.125f * e1;
            kv2[u] = kf[2 * i + u] * __builtin_amdgcn_rcpf(e1);
            KDT[d * 72 + pp] = f2bf(kf[2 * i + u] * __expf(bl - bcv));
          }
          wq[i] = pack2(qv[0], qv[1]);
          wk[i] = pack2(kv2[0], kv2[1]);
        }
        *(u32x4*)(QD + pp * 72 + q4 * 16) = (u32x4){wq[0], wq[1], wq[2], wq[3]};
        *(u32x4*)(QD + pp * 72 + q4 * 16 + 8) = (u32x4){wq[4], wq[5], wq[6], wq[7]};
        *(u32x4*)(KI + pp * 72 + q4 * 16) = (u32x4){wk[0], wk[1], wk[2], wk[3]};
        *(u32x4*)(KI + pp * 72 + q4 * 16 + 8) = (u32x4){wk[4], wk[5], wk[6], wk[7]};
      }
      __syncthreads();
      if (seg == 1) {
        bf16x8 bqf[4];
#pragma unroll
        for (int ks = 0; ks < 4; ++ks) bqf[ks] = *(const bf16x8*)(QD + (it * 32 + r) * 72 + ks * 16 + hh * 8);
        f32x16 o;
#pragma unroll
        for (int i = 0; i < 16; ++i) o[i] = 0.f;
#pragma unroll
        for (int ks = 0; ks < 4; ++ks) {
          const bf16x8 a = *(const bf16x8*)(ST + (et * 32 + r) * 72 + ks * 16 + hh * 8);
          o = MFMA(a, bqf[ks], o);
        }
        for (int jt = 0; jt <= it; ++jt) {
          f32x16 sT;
#pragma unroll
          for (int i = 0; i < 16; ++i) sT[i] = 0.f;
#pragma unroll
          for (int ks = 0; ks < 4; ++ks) {
            const bf16x8 a = *(const bf16x8*)(KI + (jt * 32 + r) * 72 + ks * 16 + hh * 8);
            sT = MFMA(a, bqf[ks], sT);
          }
          if (jt == it) {
#pragma unroll
            for (int i = 0; i < 16; ++i) {
              const int jl = (i & 3) + 8 * (i >> 2) + 4 * hh;
              if (jl > r) sT[i] = 0.f;
            }
          }
#pragma unroll
          for (int sx = 0; sx < 2; ++sx) {
            u32x4 pu;
            pu.x = pack2(sT[8 * sx + 0], sT[8 * sx + 1]); pu.y = pack2(sT[8 * sx + 2], sT[8 * sx + 3]);
            pu.z = pack2(sT[8 * sx + 4], sT[8 * sx + 5]); pu.w = pack2(sT[8 * sx + 6], sT[8 * sx + 7]);
            const u16* vp = VT + (et * 32 + r) * 72 + jt * 32 + 16 * sx + 4 * hh;
            const uint2 va = *(const uint2*)(vp);
            const uint2 vb2 = *(const uint2*)(vp + 8);
            const u32x4 vu = {va.x, va.y, vb2.x, vb2.y};
            o = MFMA(__builtin_bit_cast(bf16x8, vu), __builtin_bit_cast(bf16x8, pu), o);
          }
        }
        const int pos = c * 64 + it * 32 + r;
        const int tau = dir ? len - 1 - pos : pos;
        u16* op = od + (size_t)(base + tau) * 512 + h * 128 + eh * 64 + et * 32;
#pragma unroll
        for (int g4 = 0; g4 < 4; ++g4) {
          uint2 w;
          w.x = pack2(o[4 * g4 + 0], o[4 * g4 + 1]);
          w.y = pack2(o[4 * g4 + 2], o[4 * g4 + 3]);
          *(uint2*)(op + 8 * g4 + 4 * hh) = w;
        }
      }
      {
        f32x16 kvt;
#pragma unroll
        for (int i = 0; i < 16; ++i) kvt[i] = 0.f;
#pragma unroll
        for (int ks = 0; ks < 4; ++ks) {
          const bf16x8 a = *(const bf16x8*)(VT + (et * 32 + r) * 72 + ks * 16 + hh * 8);
          const bf16x8 bk = *(const bf16x8*)(KDT + (it * 32 + r) * 72 + ks * 16 + hh * 8);
          kvt = MFMA(a, bk, kvt);
        }
        const float decay = __expf(BC[63 * 65 + it * 32 + r]);
#pragma unroll
        for (int i = 0; i < 16; ++i) Sreg[i] = Sreg[i] * decay + kvt[i];
      }
      __syncthreads();
#pragma unroll
      for (int i = 0; i < 16; ++i) {
        const int el = (i & 3) + 8 * (i >> 2) + 4 * hh;
        ST[(et * 32 + el) * 72 + it * 32 + r] = f2bf(Sreg[i]);
      }
    }
  }
}

DI void scan_post(const P& p, int layer, int vb, int nvb) {
  const int tid_ = get_tid();
  const int lane = tid_ & 63, wave = tid_ >> 6;
  const u16* z = (const u16*)(p.ws + OFF_REGB);
  u16* o0 = (u16*)(p.ws + OFF_ODIR);
  const u16* o1 = o0 + (size_t)T * 512;
  const int nrows = layer == 0 ? T : LAT;
  const int ldz = layer == 0 ? EVEN_IN : ODD_IN;
  const int goff = layer == 0 ? 2240 : 1056;
  float on[8];
#pragma unroll
  for (int j = 0; j < 8; ++j)
    on[j] = layer == 0 ? p.ev_out_norm[(lane & 7) * 8 + j] : p.od_out_norm[(lane & 15) * 8 + j];
  for (int t = vb * 4 + wave; t < nrows; t += nvb * 4) {
    float a[8], bb[8], gt[8];
    unpack8(*(const uint4*)(o0 + (size_t)t * 512 + lane * 8), a);
    unpack8(*(const uint4*)(o1 + (size_t)t * 512 + lane * 8), bb);
    unpack8(*(const uint4*)(z + (size_t)t * ldz + goff + lane * 8), gt);
    float ss = 0.f;
#pragma unroll
    for (int j = 0; j < 8; ++j) { a[j] += bb[j]; ss += a[j] * a[j]; }
    ss += __shfl_xor(ss, 1); ss += __shfl_xor(ss, 2); ss += __shfl_xor(ss, 4);
    float rms;
    if (layer == 0) rms = rsqrtf(ss * (1.f / 64.f) + EPS);
    else { ss += __shfl_xor(ss, 8); rms = rsqrtf(ss * (1.f / 128.f) + EPS); }
#pragma unroll
    for (int j = 0; j < 8; ++j) a[j] = a[j] * rms * on[j] * silu_f(gt[j]);
    *(uint4*)(o0 + (size_t)t * 512 + lane * 8) = pack8(a);
  }
}


#define XB_TMO      128
#define XB_XCNT(j)  (256  + 64 * (j))
#define XB_XSUB(j)  (1280 + 64 * (j))
#define XB_XGEN(j)  (2304 + 64 * (j))
#define XB_TOP      3328
#define XB_TOPGEN   3392
#define XB_SPIN_CAP (1u << 18)
#define LAS __attribute__((address_space(3)))
DI unsigned xb_ld(unsigned* p) { return __hip_atomic_load(p, __ATOMIC_RELAXED, __HIP_MEMORY_SCOPE_AGENT); }
DI unsigned xb_add(unsigned* p, unsigned v) { return __hip_atomic_fetch_add(p, v, __ATOMIC_RELAXED, __HIP_MEMORY_SCOPE_AGENT); }
DI unsigned xb_xcc_id() { return (unsigned)__builtin_amdgcn_s_getreg((3 << 11) | 20) & 0xFu; }
#define XB_SPIN(cond, bar) do { unsigned _sp = 0; while (cond) { __builtin_amdgcn_s_sleep(1); \
    if ((++_sp & 255u) == 0u) { if (xb_ld(&(bar)[XB_TMO])) break; if (_sp > XB_SPIN_CAP) { atomicAdd(&(bar)[XB_TMO], 1u); break; } } } } while (0)
struct XcdBarrier { unsigned* bar; unsigned x; unsigned G; unsigned nloc; unsigned nx; };
DI XcdBarrier xcd_barrier_post(unsigned* bar, unsigned G, bool member) {
  XcdBarrier b; b.bar = bar; b.x = xb_xcc_id(); b.G = G; b.nloc = 0u; b.nx = 0u;
  if (member && threadIdx.x == 0) (void)xb_add(&bar[XB_XCNT(b.x)], 1u);
  return b;
}
DI void xcd_barrier_complete(unsigned* bar, unsigned x, unsigned G, unsigned& nloc, unsigned& nx) {
  unsigned sum, cnt, mine, sp = 0u;
  for (;;) {
    sum = 0u; cnt = 0u; mine = 0u;
#pragma unroll
    for (unsigned j = 0; j < 16; ++j) { const unsigned c = xb_ld(&bar[XB_XCNT(j)]); sum += c; cnt += (c > 0u) ? 1u : 0u; mine = (j == x) ? c : mine; }
    if (sum == G) break;
    __builtin_amdgcn_s_sleep(1);
    if ((++sp & 255u) == 0u) { if (xb_ld(&bar[XB_TMO])) break; if (sp > XB_SPIN_CAP) { atomicAdd(&bar[XB_TMO], 1u); break; } }
  }
  nloc = mine > 0u ? mine : 1u; nx = cnt > 0u ? cnt : 1u;
}
DI void xcd_barrier(XcdBarrier& b) {
  asm volatile("s_waitcnt vmcnt(0)" ::: "memory");
  __syncthreads();
  if (threadIdx.x == 0) {
    unsigned* bar = b.bar;
    __builtin_amdgcn_s_waitcnt(0);
    unsigned nloc = b.nloc, nx = b.nx;
    if (nloc == 0u) { xcd_barrier_complete(bar, b.x, b.G, nloc, nx); b.nloc = nloc; b.nx = nx; }
    const unsigned old = xb_add(&bar[XB_XSUB(b.x)], 1u);
    const unsigned gen = old / nloc;
    if (old + 1u == (gen + 1u) * nloc) {
      __builtin_amdgcn_fence(__ATOMIC_RELEASE, "agent");
      asm volatile("s_waitcnt vmcnt(0)" ::: "memory");
      const unsigned og = xb_add(&bar[XB_TOP], 1u);
      const unsigned tg = og / nx;
      if (og + 1u == (tg + 1u) * nx) xb_add(&bar[XB_TOPGEN], 1u);
      else XB_SPIN(xb_ld(&bar[XB_TOPGEN]) == tg, bar);
      __builtin_amdgcn_fence(__ATOMIC_ACQUIRE, "agent");
      xb_add(&bar[XB_XGEN(b.x)], 1u);
      asm volatile("s_waitcnt vmcnt(0)" ::: "memory");
    } else {
      XB_SPIN(xb_ld(&bar[XB_XGEN(b.x)]) == gen, bar);
      __builtin_amdgcn_fence(__ATOMIC_ACQUIRE, "agent");
      asm volatile("s_waitcnt vmcnt(0)" ::: "memory");
    }
  }
  __syncthreads();
}

DI void ffn_phases(const P& p, XcdBarrier& xb, int layer, int s, int M, char* smem, int vb, int nvb) {
  char* ws = p.ws;
  {
    GemmDesc g = gemm_simple((const u16*)(ws + OFF_REGA), 1024, (const u16*)(ws + OFF_WGU) + (size_t)s * 5632 * 1024,
                             1024, M, 5632);
    g.o16 = (u16*)(ws + OFF_REGB); g.ldo = DFF;
    gemm_auto<EPI_SWIGLU>(g, M, smem, vb, nvb);
  }
  xcd_barrier(xb);
  {
    GemmDesc g = gemm_simple((const u16*)(ws + OFF_REGB), DFF, (const u16*)(ws + OFF_WDN) + (size_t)s * 1024 * 2816,
                             DFF, M, 1024);
    g.xres = p.out; g.hres = (float*)(ws + OFF_RH);
    g.mod = (const float*)(ws + OFF_MODS) + (size_t)layer * 9 * 9216;
    g.gidx = s == 0 ? 2 : 8; g.coef = 0.5f;
    gemm_auto<EPI_RES>(g, M, smem, vb, nvb);
  }
  xcd_barrier(xb);
}

__global__ void __launch_bounds__(NTHR, 2) mega(P p) {
  extern __shared__ __attribute__((aligned(16))) char smem[];
  cg::grid_group grid = cg::this_grid();
  const int vb = blockIdx.x, nvb = gridDim.x;
  char* ws = p.ws;
  XcdBarrier xb = xcd_barrier_post((unsigned*)(ws + OFF_BAR), gridDim.x, true);
  const bool subgrid = nvb >= 512;
  XcdBarrier xb2 = xcd_barrier_post((unsigned*)(ws + OFF_BAR) + 4096, gridDim.x - 256, subgrid && vb >= 256);
  if (p.ws == nullptr) grid.sync();

  mods_phase(p, smem, vb, nvb);
  __syncthreads();
  convert_weights(p, 0, smem, vb, nvb, 0);
  xcd_barrier(xb);

  for (int layer = 0; layer < 2; ++layer) {
    const bool ctx_out = layer == 0;
    if (layer == 1) convert_weights(p, 1, smem, vb, nvb, 0);
    normmod_phase(p, layer, 0, T, layer == 0, vb, nvb);
    xcd_barrier(xb);
    ffn_phases(p, xb, layer, 0, T, smem, vb, nvb);
    normmod_phase(p, layer, 1, T, false, vb, nvb);
    xcd_barrier(xb);
    {
      GemmDesc g = gemm_simple((const u16*)(ws + OFF_REGA), 1024, (const u16*)(ws + OFF_WIN), 1024, T,
                               layer == 0 ? EVEN_PAD : ODD_PAD);
      g.o16 = (u16*)(ws + OFF_REGB);
      g.ldo = layer == 0 ? EVEN_IN : ODD_IN;
      g.nreal = g.ldo;
      g.side = (float*)(ws + OFF_SIDE);
      g.slo = layer == 0 ? 2208 : 1024;
      gemm_auto<EPI_STORE>(g, T, smem, vb, nvb);
    }
    xcd_barrier(xb);
    if (layer == 0) {
      const bool split0 = subgrid;
      const int svb = split0 ? vb - 256 : vb, snvb = split0 ? nvb - 256 : nvb;
      if (!split0 || vb < 256)
        for (int cid = vb; cid < 256; cid += (split0 ? 256 : nvb)) gdn_chain(p, cid, smem);
      __syncthreads();
      if (!split0 || vb >= 256) {
        XcdBarrier& bs = split0 ? xb2 : xb;
        {
          GemmDesc g = gemm_simple((const u16*)(ws + OFF_REGB), EVEN_IN, (const u16*)(ws + OFF_WQUP), 384, T, 768);
          g.o16 = (u16*)(ws + OFF_QB); g.ldo = 768; g.nreal = 768;
          gemm_auto<EPI_STORE>(g, T, smem, svb, snvb);
          GemmDesc g2 = gemm_simple((const u16*)(ws + OFF_REGB) + 384, EVEN_IN, (const u16*)(ws + OFF_WKVUP), 256, T, 1024);
          g2.o16 = (u16*)(ws + OFF_REGA); g2.ldo = 1024; g2.nreal = 1024;
          gemm_auto<EPI_STORE>(g2, T, smem, svb, snvb);
        }
        xcd_barrier(bs);
        mla_finalize(p, smem, svb, snvb);
        xcd_barrier(bs);
        const u16* Q = (const u16*)(ws + OFF_QB);
        const u16* Kb = (const u16*)(ws + OFF_KB);
        const u16* KV = (const u16*)(ws + OFF_REGA);
        for (int it = svb; it < 1024 + 128; it += snvb) {
          if (it < 1024) {
            const int b = it >> 7, h = (it >> 4) & 7, qt = it & 15;
            attn_item<96, false>(Q, 768, h * 96, Kb, 768, h * 96, KV, 1024, h * 128 + 64, b * SEQ + qt * 128, qt * 128,
                                 LAT + b * CTXL, b * SEQ, 0, 32, 0.f, (u16*)(ws + OFF_QB), 768, h * 96, smem);
          } else {
            const int j = it - 1024;
            const int b = j >> 4, h = (j >> 1) & 7, qt = j & 1;
            attn_item<96, false>(Q, 768, h * 96, Kb, 768, h * 96, KV, 1024, h * 128 + 64, LAT + b * CTXL + qt * 128, 0,
                                 LAT + b * CTXL, b * SEQ, 0, 0, 0.f, (u16*)(ws + OFF_QB), 768, h * 96, smem);
          }
        }
        __syncthreads();
        convert_weights(p, 0, smem, svb, snvb, 1);
      }
      xcd_barrier(xb);
      scan_post(p, 0, vb, nvb);
      xcd_barrier(xb);
      {
        GemmDesc g = gemm_simple((const u16*)(ws + OFF_QB), 768, (const u16*)(ws + OFF_WOUT), 1024, T, 1024);
        g.kstep0 = 96; g.ksplit = 8; g.A1 = (const u16*)(ws + OFF_ODIR); g.lda1 = 512;
        g.xres = p.out; g.hres = (float*)(ws + OFF_RH);
        g.mod = (const float*)(ws + OFF_MODS); g.gidx = 5; g.coef = 1.f;
        gemm_auto<EPI_RES>(g, T, smem, vb, nvb);
      }
      xcd_barrier(xb);
    } else {
      swa_finalize(p, smem, vb, nvb);
      xcd_barrier(xb);
      const bool split1 = nvb >= 256;
      if (!split1 || vb < 128)
        for (int cid = vb; cid < 128; cid += (split1 ? 128 : nvb)) gla_chain_mfma(p, cid, smem);
      __syncthreads();
      if (!split1 || vb >= 128)
      {
        const u16* Q = (const u16*)(ws + OFF_QB);
        const u16* Kb = (const u16*)(ws + OFF_KB);
        const u16* z = (const u16*)(ws + OFF_REGB);
        for (int it = (split1 ? vb - 128 : vb); it < 1024; it += (split1 ? nvb - 128 : nvb)) {
          const int b = it >> 7, h = (it >> 4) & 7, qt = it & 15;
          const int g2 = h >> 2;
          const int q0 = qt * 128;
          const int lo = (q0 - 128 < 0 ? 0 : q0 - 128) >> 6;
          const int hi = (q0 + 256 > SEQ ? SEQ : q0 + 256) >> 6;
          attn_item<64, true>(Q, 512, h * 64, Kb, 128, g2 * 64, z, ODD_IN, 2208 + g2 * 64, b * SEQ + q0, q0,
                              LAT + b * CTXL, b * SEQ, lo, hi, p.od_sink[h] * LOG2E, (u16*)(ws + OFF_REGA), 512, h * 64,
                              smem);
        }
        __syncthreads();
        convert_weights(p, 1, smem, split1 ? vb - 128 : vb, split1 ? nvb - 128 : nvb, 1);
      }
      xcd_barrier(xb);
      scan_post(p, 1, vb, nvb);
      xcd_barrier(xb);
      {
        GemmDesc g = gemm_simple((const u16*)(ws + OFF_ODIR), 512, (const u16*)(ws + OFF_WOUT), 1024, LAT, 1024);
        g.kstep0 = 64; g.ksplit = 8; g.A1 = (const u16*)(ws + OFF_REGA); g.lda1 = 512;
        g.xres = p.out; g.hres = (float*)(ws + OFF_RH);
        g.mod = (const float*)(ws + OFF_MODS) + (size_t)9 * 9216; g.gidx = 5; g.coef = 1.f;
        gemm_auto<EPI_RES>(g, LAT, smem, vb, nvb);
      }
      xcd_barrier(xb);
    }
    const int M2 = ctx_out ? T : LAT;
    normmod_phase(p, layer, 2, M2, false, vb, nvb);
    xcd_barrier(xb);
    ffn_phases(p, xb, layer, 1, M2, smem, vb, nvb);
  }
}

extern "C" void kernel_launch(void* const* d_in, const int* in_sizes, int n_in, void* d_out, int out_size, void* d_ws,
                              size_t ws_size, hipStream_t stream) {
  static int grid_blocks = 0;
  if (!grid_blocks) {
    int dev = 0, cus = 0, per_cu = 0;
    hipGetDevice(&dev);
    hipDeviceGetAttribute(&cus, hipDeviceAttributeMultiprocessorCount, dev);
    hipFuncSetAttribute((const void*)mega, hipFuncAttributeMaxDynamicSharedMemorySize, SMEM_BYTES);
    hipOccupancyMaxActiveBlocksPerMultiprocessor(&per_cu, mega, NTHR, SMEM_BYTES);
    if (per_cu > 2) per_cu = 2;
    grid_blocks = cus * per_cu;
    if (ws_size < WS_NEED) fprintf(stderr, "workspace too small: %zu < %zu\n", ws_size, (size_t)WS_NEED);
  }
  P p{};
  const float* const* in = (const float* const*)d_in;
  p.x = in[0]; p.c = in[1]; p.ctx = in[2]; p.c_ctx = in[3]; p.ada_w = in[4]; p.ada_b = in[5]; p.norm_g = in[6];
  p.ffn_g = in[7]; p.ffn_u = in[8]; p.ffn_d = in[9];
  p.ev_w_in = in[10]; p.ev_q_a_norm = in[11]; p.ev_w_q_up = in[12]; p.ev_kv_a_norm = in[13]; p.ev_w_kv_up = in[14];
  p.ev_q_norm = in[15]; p.ev_k_norm = in[16]; p.ev_conv = in[17]; p.ev_a_log = in[18]; p.ev_dt_bias = in[19];
  p.ev_out_norm = in[20]; p.ev_w_out = in[21];
  p.od_w_in = in[22]; p.od_w2 = in[23]; p.od_gb = in[24]; p.od_out_norm = in[25]; p.od_q_norm = in[26];
  p.od_k_norm = in[27]; p.od_sink = in[28]; p.od_w_out = in[29];
  p.out = (float*)d_out;
  p.ws = (char*)d_ws;
  hipMemsetAsync((char*)d_ws + OFF_BAR, 0, 32768, stream);
  void* args[] = {&p};
  hipError_t e = hipLaunchCooperativeKernel((const void*)mega, dim3(grid_blocks), dim3(NTHR), args, SMEM_BYTES, stream);
  if (e != hipSuccess) fprintf(stderr, "cooperative launch failed: %s (grid %d)\n", hipGetErrorString(e), grid_blocks);
}
```

```cpp
#include <hip/hip_runtime.h>
#include <hip/hip_cooperative_groups.h>
#include <cstdio>
namespace cg = cooperative_groups;

#define DI __device__ __forceinline__
typedef unsigned short u16;
typedef short bf16x8 __attribute__((ext_vector_type(8)));
typedef float f32x16 __attribute__((ext_vector_type(16)));
typedef unsigned u32x4 __attribute__((ext_vector_type(4)));
typedef float f32x2 __attribute__((ext_vector_type(2)));
typedef float f32x4v __attribute__((ext_vector_type(4)));
#define LAS3 __attribute__((address_space(3)))
#define MFMA(a, b, c) __builtin_amdgcn_mfma_f32_32x32x16_bf16((a), (b), (c), 0, 0, 0)

constexpr int D = 1024, NB = 8, SEQ = 2048, CTXL = 256;
constexpr int LAT = NB * SEQ, NCTX = NB * CTXL, T = LAT + NCTX;
constexpr int DFF = 2816;
constexpr int EVEN_IN = 2752, EVEN_PAD = 2816, ODD_IN = 2336, ODD_PAD = 2432;
constexpr float EPS = 1e-6f;
constexpr float LOG2E = 1.4426950408889634f;
constexpr int NTHR = 256;
constexpr int SMEM_BYTES = 81920;

constexpr size_t OFF_WGU = 0;
constexpr size_t OFF_WDN = OFF_WGU + 2ull * 5632 * 1024 * 2;
constexpr size_t OFF_WIN = OFF_WDN + 2ull * 1024 * 2816 * 2;
constexpr size_t OFF_WQUP = OFF_WIN + 2816ull * 1024 * 2;
constexpr size_t OFF_WKVUP = OFF_WQUP + 768ull * 384 * 2;
constexpr size_t OFF_WOUT = OFF_WKVUP + 1024ull * 256 * 2;
constexpr size_t OFF_MODS = OFF_WOUT + 1024ull * 1024 * 2;
constexpr size_t OFF_RH = OFF_MODS + 2ull * 9 * 9216 * 4;
constexpr size_t OFF_SIDE = OFF_RH + 2048ull * 1024 * 4;
constexpr size_t OFF_REGA = OFF_SIDE + (size_t)T * 32 * 4;
constexpr size_t OFF_REGB = OFF_REGA + (size_t)T * 1024 * 2;
constexpr size_t OFF_QB = OFF_REGB + (size_t)T * 2816 * 2;
constexpr size_t OFF_KB = OFF_QB + (size_t)T * 768 * 2;
constexpr size_t OFF_ODIR = OFF_KB + (size_t)T * 768 * 2;
constexpr size_t OFF_BAR = OFF_ODIR + 2ull * T * 512 * 2;
constexpr size_t WS_NEED = OFF_BAR + 32768;

struct P {
  const float *x, *c, *ctx, *c_ctx, *ada_w, *ada_b, *norm_g, *ffn_g, *ffn_u, *ffn_d;
  const float *ev_w_in, *ev_q_a_norm, *ev_w_q_up, *ev_kv_a_norm, *ev_w_kv_up, *ev_q_norm, *ev_k_norm, *ev_conv,
      *ev_a_log, *ev_dt_bias, *ev_out_norm, *ev_w_out;
  const float *od_w_in, *od_w2, *od_gb, *od_out_norm, *od_q_norm, *od_k_norm, *od_sink, *od_w_out;
  float* out;
  char* ws;
};

DI int get_tid() {
  int t = threadIdx.x;
  asm volatile("" : "+v"(t));
  return t;
}
DI u16 f2bf(float x) {
  return __builtin_bit_cast(u16, (__bf16)x);
}
DI float bf2f(u16 v) { return __uint_as_float(((unsigned)v) << 16); }
typedef __bf16 bf16x2v __attribute__((ext_vector_type(2)));
DI unsigned pack2(float a, float b) {
  const f32x2 v = {a, b};
  return __builtin_bit_cast(unsigned, __builtin_convertvector(v, bf16x2v));
}
DI float bflo(unsigned w) { return __uint_as_float(w << 16); }
DI float bfhi(unsigned w) { return __uint_as_float(w & 0xffff0000u); }
DI void unpack8(uint4 v, float* f) {
  f[0] = bflo(v.x); f[1] = bfhi(v.x); f[2] = bflo(v.y); f[3] = bfhi(v.y);
  f[4] = bflo(v.z); f[5] = bfhi(v.z); f[6] = bflo(v.w); f[7] = bfhi(v.w);
}
DI void unpack8v(u32x4 v, float* f) {
  f[0] = bflo(v.x); f[1] = bfhi(v.x); f[2] = bflo(v.y); f[3] = bfhi(v.y);
  f[4] = bflo(v.z); f[5] = bfhi(v.z); f[6] = bflo(v.w); f[7] = bfhi(v.w);
}
DI uint4 pack8(const float* f) {
  uint4 v;
  v.x = pack2(f[0], f[1]); v.y = pack2(f[2], f[3]); v.z = pack2(f[4], f[5]); v.w = pack2(f[6], f[7]);
  return v;
}
DI float wave_sum(float v) {
  v += __shfl_xor(v, 32); v += __shfl_xor(v, 16); v += __shfl_xor(v, 8);
  v += __shfl_xor(v, 4); v += __shfl_xor(v, 2); v += __shfl_xor(v, 1);
  return v;
}
DI float quad_sum(float v) {
  v += __builtin_bit_cast(float, __builtin_amdgcn_mov_dpp(__builtin_bit_cast(int, v), 0xB1, 0xF, 0xF, true));
  v += __builtin_bit_cast(float, __builtin_amdgcn_mov_dpp(__builtin_bit_cast(int, v), 0x4E, 0xF, 0xF, true));
  return v;
}
DI float row16_sum(float v) {
  v += __builtin_bit_cast(float, __builtin_amdgcn_mov_dpp(__builtin_bit_cast(int, v), 0xB1, 0xF, 0xF, true));
  v += __builtin_bit_cast(float, __builtin_amdgcn_mov_dpp(__builtin_bit_cast(int, v), 0x4E, 0xF, 0xF, true));
  v += __builtin_bit_cast(float, __builtin_amdgcn_mov_dpp(__builtin_bit_cast(int, v), 0x141, 0xF, 0xF, true));
  v += __builtin_bit_cast(float, __builtin_amdgcn_mov_dpp(__builtin_bit_cast(int, v), 0x140, 0xF, 0xF, true));
  return v;
}
DI float row8_sum(float v) {
  v += __builtin_bit_cast(float, __builtin_amdgcn_mov_dpp(__builtin_bit_cast(int, v), 0xB1, 0xF, 0xF, true));
  v += __builtin_bit_cast(float, __builtin_amdgcn_mov_dpp(__builtin_bit_cast(int, v), 0x4E, 0xF, 0xF, true));
  v += __builtin_bit_cast(float, __builtin_amdgcn_mov_dpp(__builtin_bit_cast(int, v), 0x141, 0xF, 0xF, true));
  return v;
}
DI void wave_lds_sync() {
  asm volatile("s_waitcnt lgkmcnt(0)" ::: "memory");
  __builtin_amdgcn_wave_barrier();
}
DI float silu_f(float x) { return x * __builtin_amdgcn_rcpf(1.f + __expf(-x)); }
DI float sigmoid_f(float x) { return __builtin_amdgcn_rcpf(1.f + __expf(-x)); }
DI float softplus_f(float x) { return x > 20.f ? x : log1pf(__expf(x)); }

DI void conv_tile(const float* __restrict__ src, int N, u16* __restrict__ dst, int ldd, int k0, int n0, int mode,
                  const float* __restrict__ kscale, float* tl) {
  const int t = get_tid();
  const int r = t >> 4, c4 = (t & 15) * 4;
#pragma unroll
  for (int i = 0; i < 4; ++i) {
    const int k = r + 16 * i;
    float4 v = make_float4(0.f, 0.f, 0.f, 0.f);
    if (n0 + c4 < N) v = *(const float4*)(src + (size_t)(k0 + k) * N + n0 + c4);
    if (kscale) { const float s = kscale[k0 + k]; v.x *= s; v.y *= s; v.z *= s; v.w *= s; }
    float* q = tl + k * 65 + c4;
    q[0] = v.x; q[1] = v.y; q[2] = v.z; q[3] = v.w;
  }
  __syncthreads();
  const int n = t >> 2, ks = (t & 3) * 16;
  unsigned w[8];
#pragma unroll
  for (int j = 0; j < 8; ++j) w[j] = pack2(tl[(ks + 2 * j) * 65 + n], tl[(ks + 2 * j + 1) * 65 + n]);
  const int nn = n0 + n;
  const int drow = mode == 0 ? nn : ((nn >> 5) * 64 + (nn & 31) + (mode == 2 ? 32 : 0));
  uint4* d = (uint4*)(dst + (size_t)drow * ldd + k0 + ks);
  d[0] = make_uint4(w[0], w[1], w[2], w[3]);
  d[1] = make_uint4(w[4], w[5], w[6], w[7]);
  __syncthreads();
}

DI void convert_weights(const P& p, int layer, char* smem, int vb, int nvb, int part) {
  float* tl = (float*)smem;
  char* ws = p.ws;
  const int nFF = 704;
  const int nIn = (layer == 0 ? EVEN_PAD : ODD_PAD) / 64 * 16;
  const int nQ = layer == 0 ? 72 : 0, nKV = layer == 0 ? 64 : 0;
  const int nEarly = 3 * nFF + nIn + nQ + nKV, nLate = 3 * nFF + 256;
  const int total = part == 0 ? nEarly : nLate;
  for (int job = vb; job < total; job += nvb) {
    int j = part == 0 ? (job < 3 * nFF ? job : job + 3 * nFF)
                      : (job < 3 * nFF ? job + 3 * nFF : 6 * nFF + nIn + nQ + nKV + (job - 3 * nFF));
    if (j < 6 * nFF) {
      const int s = j / (3 * nFF);
      int jj = j % (3 * nFF);
      const int which = jj / nFF;
      jj %= nFF;
      const size_t woff = ((size_t)layer * 2 + s) * 1024 * 2816;
      if (which < 2) {
        const float* src = (which == 0 ? p.ffn_g : p.ffn_u) + woff;
        u16* dst = (u16*)(ws + OFF_WGU) + (size_t)s * 5632 * 1024;
        conv_tile(src, 2816, dst, 1024, (jj / 44) * 64, (jj % 44) * 64, 1 + which, nullptr, tl);
      } else {
        const float* src = p.ffn_d + woff;
        u16* dst = (u16*)(ws + OFF_WDN) + (size_t)s * 1024 * 2816;
        conv_tile(src, 1024, dst, 2816, (jj / 16) * 64, (jj % 16) * 64, 0, nullptr, tl);
      }
      continue;
    }
    j -= 6 * nFF;
    if (j < nIn) {
      const int N = layer == 0 ? EVEN_IN : ODD_IN;
      const int ntn = (layer == 0 ? EVEN_PAD : ODD_PAD) / 64;
      const float* src = layer == 0 ? p.ev_w_in : p.od_w_in;
      conv_tile(src, N, (u16*)(ws + OFF_WIN), 1024, (j / ntn) * 64, (j % ntn) * 64, 0, nullptr, tl);
      continue;
    }
    j -= nIn;
    if (j < nQ) {
      conv_tile(p.ev_w_q_up, 768, (u16*)(ws + OFF_WQUP), 384, (j / 12) * 64, (j % 12) * 64, 0, p.ev_q_a_norm, tl);
      continue;
    }
    j -= nQ;
    if (j < nKV) {
      conv_tile(p.ev_w_kv_up, 1024, (u16*)(ws + OFF_WKVUP), 256, (j / 16) * 64, (j % 16) * 64, 0, p.ev_kv_a_norm, tl);
      continue;
    }
    j -= nKV;
    {
      const float* src = layer == 0 ? p.ev_w_out : p.od_w_out;
      conv_tile(src, 1024, (u16*)(ws + OFF_WOUT), 1024, (j / 16) * 64, (j % 16) * 64, 0, nullptr, tl);
    }
  }
}

DI void mods_phase(const P& p, char* smem, int vb, int nvb) {
  float* sc = (float*)smem;
  float* red = sc + 9 * 1024;
  float* mods = (float*)(p.ws + OFF_MODS);
  const int t = get_tid();
  bool loaded = false;
  for (int job = vb; job < 576; job += nvb) {
    if (!loaded) {
      for (int i = t; i < 9 * 1024; i += NTHR) {
        const float v = i < 8192 ? p.c[i] : p.c_ctx[i - 8192];
        sc[i] = silu_f(v);
      }
      loaded = true;
      __syncthreads();
    }
    const int l = job / 288, n0 = (job % 288) * 32;
    const int c4 = (t & 7) * 4, ksl = t >> 3;
    float4 acc[9];
#pragma unroll
    for (int r = 0; r < 9; ++r) acc[r] = make_float4(0.f, 0.f, 0.f, 0.f);
    const float* w = p.ada_w + (size_t)l * 1024 * 9216 + n0 + c4;
#pragma unroll 8
    for (int kk = 0; kk < 32; ++kk) {
      const int k = ksl * 32 + kk;
      const float4 wv = *(const float4*)(w + (size_t)k * 9216);
#pragma unroll
      for (int r = 0; r < 9; ++r) {
        const float sv = sc[r * 1024 + k];
        acc[r].x += sv * wv.x; acc[r].y += sv * wv.y; acc[r].z += sv * wv.z; acc[r].w += sv * wv.w;
      }
    }
#pragma unroll
    for (int r = 0; r < 9; ++r) *(float4*)(red + (ksl * 9 + r) * 32 + c4) = acc[r];
    __syncthreads();
    for (int i = t; i < 9 * 32; i += NTHR) {
      const int r = i >> 5, cc = i & 31;
      float v = p.ada_b[(size_t)l * 9216 + n0 + cc];
#pragma unroll
      for (int sl = 0; sl < 32; ++sl) v += red[(sl * 9 + r) * 32 + cc];
      mods[((size_t)l * 9 + r) * 9216 + n0 + cc] = v;
    }
    __syncthreads();
  }
}

DI void normmod_phase(const P& p, int layer, int which, int nrows, bool first, int vb, int nvb) {
  const int tid_ = get_tid();
  const int lane = tid_ & 63, wave = tid_ >> 6;
  u16* dst = (u16*)(p.ws + OFF_REGA);
  float* rh = (float*)(p.ws + OFF_RH);
  const float* mods = (const float*)(p.ws + OFF_MODS) + (size_t)layer * 9 * 9216;
  const float* g = p.norm_g + ((size_t)layer * 3 + which) * 1024;
  const int shift_i = which * 3, scale_i = which * 3 + 1;
  const int nw = nvb * 4;
  const int per = (nrows + nw - 1) / nw;
  const int row0 = (vb * 4 + wave) * per;
  const int row1 = row0 + per < nrows ? row0 + per : nrows;
  f32x4v gg[4], sh[4], sc1[4];
#pragma unroll
  for (int i = 0; i < 4; ++i) {
    gg[i] = *(const f32x4v*)(g + i * 256 + lane * 4);
    sh[i] = (f32x4v){0.f, 0.f, 0.f, 0.f};
    sc1[i] = (f32x4v){1.f, 1.f, 1.f, 1.f};
  }
  int crg = -1;
  for (int row = row0; row < row1; ++row) {
    const float* src;
    float* res = row < LAT ? p.out + (size_t)row * 1024 : rh + (size_t)(row - LAT) * 1024;
    if (first) src = row < LAT ? p.x + (size_t)row * 1024 : p.ctx + (size_t)(row - LAT) * 1024;
    else src = res;
    const int rg = row < LAT ? (row >> 11) : 8;
    if (rg != crg) {
      const float* mrow = mods + (size_t)rg * 9216;
#pragma unroll
      for (int i = 0; i < 4; ++i) {
        sh[i] = *(const f32x4v*)(mrow + shift_i * 1024 + i * 256 + lane * 4);
        sc1[i] = *(const f32x4v*)(mrow + scale_i * 1024 + i * 256 + lane * 4) + 1.f;
        sc1[i] *= gg[i];
      }
      crg = rg;
    }
    f32x4v v[4];
    float ss = 0.f;
#pragma unroll
    for (int i = 0; i < 4; ++i) {
      v[i] = *(const f32x4v*)(src + i * 256 + lane * 4);
      ss += v[i].x * v[i].x + v[i].y * v[i].y + v[i].z * v[i].z + v[i].w * v[i].w;
    }
    ss = wave_sum(ss);
    const float rinv = rsqrtf(ss * (1.f / 1024.f) + EPS);
#pragma unroll
    for (int i = 0; i < 4; ++i) {
      const int col = i * 256 + lane * 4;
      if (first) *(f32x4v*)(res + col) = v[i];
      const f32x4v y = v[i] * rinv * sc1[i] + sh[i];
      uint2 o;
      o.x = pack2(y.x, y.y); o.y = pack2(y.z, y.w);
      *(uint2*)(dst + (size_t)row * 1024 + col) = o;
    }
  }
}

struct GemmDesc {
  const u16* A0; int lda0; int kstep0; int ksplit;
  const u16* A1; int lda1;
  const u16* Bt; int K; int nM; int nN;
  u16* o16; int ldo; int nreal; float* side; int slo;
  float* xres; float* hres; const float* mod; int gidx; float coef;
};
constexpr int EPI_SWIGLU = 0, EPI_RES = 1, EPI_STORE = 2;

template <int EPI, int MI>
DI void gemm_tile(const GemmDesc& g, int tm, int tn, char* smem) {
  constexpr int BM = 64 * MI, ABYTES = BM * 128;
  char* As = smem;
  char* Bs = smem + 2 * ABYTES;
  const int tid = get_tid(), lane = tid & 63, wave = tid >> 6, r = lane & 31, hh = lane >> 5;
  const int wm = wave >> 1, wn = wave & 1;
  const int m0 = tm * BM, n0 = tn * 128;
  const int nk = g.K >> 6;
  f32x16 acc[MI][2];
#pragma unroll
  for (int a = 0; a < MI; ++a)
#pragma unroll
    for (int b = 0; b < 2; ++b)
#pragma unroll
      for (int i = 0; i < 16; ++i) acc[a][b][i] = 0.f;
  const int srow = tid >> 3;
  const int schunk = (tid & 7) ^ ((srow & 7) ^ ((srow >> 3) & 3));
#define G_GLDS(KT, BUF)                                                                               \
  {                                                                                                   \
    const int kt_ = (KT);                                                                             \
    const u16* Ab_; int lda_;                                                                         \
    if (kt_ < g.ksplit) { Ab_ = g.A0 + kt_ * g.kstep0; lda_ = g.lda0; }                              \
    else { Ab_ = g.A1 + (kt_ - g.ksplit) * 64; lda_ = g.lda1; }                                       \
    const u16* pa_ = Ab_ + (size_t)(m0 + srow) * lda_ + schunk * 8;                                   \
    const u16* pb_ = g.Bt + (size_t)(n0 + srow) * g.K + kt_ * 64 + schunk * 8;                        \
    char* la_ = As + (BUF) * ABYTES + tid * 16;                                                       \
    char* lb_ = Bs + (BUF) * 16384 + tid * 16;                                                        \
    _Pragma("unroll") for (int i = 0; i < 2 * MI; ++i)                                                \
      __builtin_amdgcn_global_load_lds((const unsigned*)(pa_ + (size_t)(32 * i) * lda_),             \
                                       (LAS3 unsigned*)(la_ + i * 4096), 16, 0, 0);                   \
    _Pragma("unroll") for (int i = 0; i < 4; ++i)                                                     \
      __builtin_amdgcn_global_load_lds((const unsigned*)(pb_ + (size_t)(32 * i) * g.K),              \
                                       (LAS3 unsigned*)(lb_ + i * 4096), 16, 0, 0);                   \
  }
  const int rowA = wm * (32 * MI) + r, rowB = wn * 64 + r;
  const int hk = hh ^ ((r & 7) ^ ((r >> 3) & 3));
#define G_COMPUTE(BUF)                                                                                \
  {                                                                                                   \
    const char* Ab = As + (BUF) * ABYTES + rowA * 128;                                                \
    const char* Bb = Bs + (BUF) * 16384 + rowB * 128;                                                 \
    _Pragma("unroll") for (int ks = 0; ks < 4; ++ks) {                                                \
      const int oc = (hk ^ (ks * 2)) << 4;                                                            \
      const bf16x8 b0 = *(const bf16x8*)(Bb + oc);                                                    \
      const bf16x8 b1 = *(const bf16x8*)(Bb + 32 * 128 + oc);                                         \
      _Pragma("unroll") for (int mi = 0; mi < MI; ++mi) {                                             \
        const bf16x8 a0 = *(const bf16x8*)(Ab + mi * 32 * 128 + oc);                                  \
        acc[mi][0] = MFMA(a0, b0, acc[mi][0]);                                                        \
        acc[mi][1] = MFMA(a0, b1, acc[mi][1]);                                                        \
      }                                                                                               \
    }                                                                                                 \
  }
  G_GLDS(0, 0);
  asm volatile("s_waitcnt vmcnt(0)" ::: "memory");
  __syncthreads();
  for (int kt = 0; kt < nk; kt += 2) {
    if (kt + 1 < nk) G_GLDS(kt + 1, 1);
    G_COMPUTE(0);
    asm volatile("s_waitcnt vmcnt(0)" ::: "memory");
    __syncthreads();
    if (kt + 1 < nk) {
      if (kt + 2 < nk) G_GLDS(kt + 2, 0);
      G_COMPUTE(1);
      asm volatile("s_waitcnt vmcnt(0)" ::: "memory");
      __syncthreads();
    }
  }
#undef G_GLDS
#undef G_COMPUTE
  if (EPI == EPI_SWIGLU) {
    u16* es = (u16*)smem;
#pragma unroll
    for (int mi = 0; mi < MI; ++mi)
#pragma unroll
      for (int i = 0; i < 16; ++i) {
        const int lrow = wm * (32 * MI) + mi * 32 + (i & 3) + 8 * (i >> 2) + 4 * hh;
        es[lrow * 64 + wn * 32 + r] = f2bf(silu_f(acc[mi][0][i]) * acc[mi][1][i]);
      }
    __syncthreads();
#pragma unroll
    for (int j = 0; j < 2 * MI; ++j) {
      const int lrow = (tid >> 3) + 32 * j, ch = tid & 7;
      const u32x4 v = *(const u32x4*)(es + lrow * 64 + ch * 8);
      *(u32x4*)(g.o16 + (size_t)(m0 + lrow) * g.ldo + (n0 >> 1) + ch * 8) = v;
    }
    __syncthreads();
  } else if (EPI == EPI_RES) {
    float* es = (float*)smem;
    const int c4 = (tid & 31) * 4;
    const int rgA = m0 < LAT ? (m0 >> 11) : 8;
    const int mlast = m0 + BM - 1;
    const int rgB = mlast < LAT ? (mlast >> 11) : 8;
    const f32x4v m4a = *(const f32x4v*)(g.mod + (size_t)rgA * 9216 + g.gidx * 1024 + n0 + c4);
    const f32x4v m4b = *(const f32x4v*)(g.mod + (size_t)rgB * 9216 + g.gidx * 1024 + n0 + c4);
#pragma unroll
    for (int mi = 0; mi < MI; ++mi) {
#pragma unroll
      for (int ni = 0; ni < 2; ++ni)
#pragma unroll
        for (int i = 0; i < 16; ++i) {
          const int lrow = wm * 32 + (i & 3) + 8 * (i >> 2) + 4 * hh;
          es[lrow * 128 + wn * 64 + ni * 32 + r] = acc[mi][ni][i];
        }
      __syncthreads();
#pragma unroll 4
      for (int j = 0; j < 8; ++j) {
        const int lrow = (tid >> 5) + 8 * j;
        const int grow = m0 + (lrow >> 5) * (32 * MI) + mi * 32 + (lrow & 31);
        const f32x4v a4 = *(const f32x4v*)(es + lrow * 128 + c4);
        const int rg = grow < LAT ? (grow >> 11) : 8;
        const f32x4v m4 = rg == rgA ? m4a : m4b;
        float* rp = (grow < LAT ? g.xres + (size_t)grow * 1024 : g.hres + (size_t)(grow - LAT) * 1024) + n0 + c4;
        f32x4v x4 = *(const f32x4v*)rp;
        x4 += (m4 * a4) * g.coef;
        *(f32x4v*)rp = x4;
      }
      __syncthreads();
    }
  } else {
    u16* es = (u16*)smem;
#pragma unroll
    for (int mi = 0; mi < MI; ++mi)
#pragma unroll
      for (int ni = 0; ni < 2; ++ni)
#pragma unroll
        for (int i = 0; i < 16; ++i) {
          const int lrow = wm * (32 * MI) + mi * 32 + (i & 3) + 8 * (i >> 2) + 4 * hh;
          const int col = n0 + wn * 64 + ni * 32 + r;
          const float v = acc[mi][ni][i];
          es[lrow * 128 + wn * 64 + ni * 32 + r] = f2bf(v);
          if (g.side != nullptr && col >= g.slo && col < g.slo + 32) g.side[(size_t)(m0 + lrow) * 32 + col - g.slo] = v;
        }
    __syncthreads();
#pragma unroll
    for (int j = 0; j < 4 * MI; ++j) {
      const int lrow = (tid >> 4) + 16 * j, ch = tid & 15;
      const int col = n0 + ch * 8;
      if (col < g.nreal) *(u32x4*)(g.o16 + (size_t)(m0 + lrow) * g.ldo + col) = *(const u32x4*)(es + lrow * 128 + ch * 8);
    }
    __syncthreads();
  }
}

template <int EPI, int MI>
DI void gemm_phase(const GemmDesc& g, char* smem, int vb, int nvb) {
  const bool xm = (nvb & 7) == 0 && (g.nM & 7) == 0;
  const int xcd = vb & 7;
  const int mPer = xm ? (g.nM >> 3) : g.nM;
  const int PM = (mPer % 9 == 0) ? 9 : ((mPer & 7) == 0 ? 8 : ((mPer % 6) == 0 ? 6 : mPer));
  const int per = PM * g.nN;
  const int local = mPer * g.nN;
  const int start = xm ? (vb >> 3) : vb, step = xm ? (nvb >> 3) : nvb;
  const int mbase = xm ? xcd * mPer : 0;
  for (int q = start; q < local; q += step) {
    const int mg = q / per;
    const int rem = q - mg * per;
    const int tn = rem / PM;
    const int tm = mbase + mg * PM + (rem - tn * PM);
    gemm_tile<EPI, MI>(g, tm, tn, smem);
  }
}
template <int EPI>
DI void gemm_auto(GemmDesc& g, int M, char* smem, int vb, int nvb) {
  if (M == T) { g.nM = T / 192; gemm_phase<EPI, 3>(g, smem, vb, nvb); }
  else { g.nM = M / 128; gemm_phase<EPI, 2>(g, smem, vb, nvb); }
}

DI GemmDesc gemm_simple(const u16* A, int lda, const u16* Bt, int K, int M, int Npad) {
  GemmDesc g;
  g.A0 = A; g.lda0 = lda; g.kstep0 = 64; g.ksplit = 1 << 20; g.A1 = A; g.lda1 = lda;
  g.Bt = Bt; g.K = K; g.nM = M / 128; g.nN = Npad / 128;
  g.o16 = nullptr; g.ldo = 0; g.nreal = 0; g.side = nullptr; g.slo = 0;
  g.xres = nullptr; g.hres = nullptr; g.mod = nullptr; g.gidx = 0; g.coef = 0.f;
  return g;
}

DI void mla_finalize(const P& p, char* smem, int vb, int nvb) {
  const int tid_ = get_tid();
  const int lane = tid_ & 63, wave = tid_ >> 6;
  const u16* z = (const u16*)(p.ws + OFF_REGB);
  u16* Q = (u16*)(p.ws + OFF_QB);
  u16* Kb = (u16*)(p.ws + OFF_KB);
  u16* KV = (u16*)(p.ws + OFF_REGA);
  float* sq = (float*)smem + wave * 1824;
  float* skv = sq + 768;
  float* skr = skv + 1024;
  const int h = lane >> 3, sub = lane & 7;
  const float QSCALE = 0.10206207261596575f * LOG2E;
  float qn[12], kn[12];
#pragma unroll
  for (int j = 0; j < 12; ++j) { qn[j] = p.ev_q_norm[sub + 8 * j]; kn[j] = p.ev_k_norm[sub + 8 * j]; }
  for (int t = vb * 4 + wave; t < T; t += nvb * 4) {
    float f[8];
    {
      uint4 v = *(const uint4*)(Q + (size_t)t * 768 + lane * 8);
      unpack8(v, f);
#pragma unroll
      for (int j = 0; j < 8; ++j) sq[lane * 8 + j] = f[j];
      if (lane < 32) {
        v = *(const uint4*)(Q + (size_t)t * 768 + (lane + 64) * 8);
        unpack8(v, f);
#pragma unroll
        for (int j = 0; j < 8; ++j) sq[(lane + 64) * 8 + j] = f[j];
      }
    }
    uint4 kv0 = *(const uint4*)(KV + (size_t)t * 1024 + lane * 8);
    uint4 kv1 = *(const uint4*)(KV + (size_t)t * 1024 + (lane + 64) * 8);
    unpack8(kv0, f);
#pragma unroll
    for (int j = 0; j < 8; ++j) skv[lane * 8 + j] = f[j];
    unpack8(kv1, f);
#pragma unroll
    for (int j = 0; j < 8; ++j) skv[(lane + 64) * 8 + j] = f[j];
    if (lane < 32) skr[lane] = bf2f(z[(size_t)t * EVEN_IN + 640 + lane]);
    float ssq = 0.f, sskv = 0.f;
    if (lane < 48) {
      uint4 v = *(const uint4*)(z + (size_t)t * EVEN_IN + lane * 8);
      unpack8(v, f);
#pragma unroll
      for (int j = 0; j < 8; ++j) ssq += f[j] * f[j];
    }
    if (lane < 32) {
      uint4 v = *(const uint4*)(z + (size_t)t * EVEN_IN + 384 + lane * 8);
      unpack8(v, f);
#pragma unroll
      for (int j = 0; j < 8; ++j) sskv += f[j] * f[j];
    }
    ssq = wave_sum(ssq);
    sskv = wave_sum(sskv);
    const float rq = rsqrtf(ssq * (1.f / 384.f) + EPS), rkv = rsqrtf(sskv * (1.f / 256.f) + EPS);
    const bool lat = t < LAT;
    const int pos = t & 2047;
    float cs = 1.f, sn = 0.f;
    if (lat) {
      const int fi = lane & 7;
      const float inv = exp2f(-(float)fi * (13.287712379549449f / 8.f));
      const float pc = (lane & 8) ? (float)(pos & 63) : (float)(pos >> 6);
      float rev = pc * inv * 0.15915494309189535f;
      rev -= floorf(rev);
      cs = __builtin_amdgcn_cosf(rev);
      sn = __builtin_amdgcn_sinf(rev);
    }
    const float c0 = __shfl(cs, sub), s0 = __shfl(sn, sub), c1 = __shfl(cs, sub + 8), s1 = __shfl(sn, sub + 8);
    wave_lds_sync();
    float y[12];
    float ss = 0.f;
#pragma unroll
    for (int j = 0; j < 12; ++j) { y[j] = sq[h * 96 + sub + 8 * j] * rq; ss += y[j] * y[j]; }
    ss += __shfl_xor(ss, 1); ss += __shfl_xor(ss, 2); ss += __shfl_xor(ss, 4);
    float rms = rsqrtf(ss * (1.f / 96.f) + EPS);
#pragma unroll
    for (int j = 0; j < 12; ++j) y[j] *= rms * qn[j];
    if (lat) {
      const float a8 = y[8] * c0 - y[10] * s0, a10 = y[8] * s0 + y[10] * c0;
      const float a9 = y[9] * c1 - y[11] * s1, a11 = y[9] * s1 + y[11] * c1;
      y[8] = a8; y[10] = a10; y[9] = a9; y[11] = a11;
    }
    float kk[12];
    float ssk = 0.f;
#pragma unroll
    for (int j = 0; j < 12; ++j) {
      kk[j] = j < 8 ? skv[h * 128 + sub + 8 * j] * rkv : skr[sub + 8 * j - 64];
      ssk += kk[j] * kk[j];
    }
    ssk += __shfl_xor(ssk, 1); ssk += __shfl_xor(ssk, 2); ssk += __shfl_xor(ssk, 4);
    rms = rsqrtf(ssk * (1.f / 96.f) + EPS);
#pragma unroll
    for (int j = 0; j < 12; ++j) kk[j] *= rms * kn[j];
    if (lat) {
      const float a8 = kk[8] * c0 - kk[10] * s0, a10 = kk[8] * s0 + kk[10] * c0;
      const float a9 = kk[9] * c1 - kk[11] * s1, a11 = kk[9] * s1 + kk[11] * c1;
      kk[8] = a8; kk[10] = a10; kk[9] = a9; kk[11] = a11;
    }
    wave_lds_sync();
#pragma unroll
    for (int j = 0; j < 12; ++j) sq[h * 96 + sub + 8 * j] = y[j] * QSCALE;
    wave_lds_sync();
    {
      *(uint4*)(Q + (size_t)t * 768 + lane * 8) = pack8(sq + lane * 8);
      if (lane < 32) *(uint4*)(Q + (size_t)t * 768 + (lane + 64) * 8) = pack8(sq + (lane + 64) * 8);
    }
    wave_lds_sync();
#pragma unroll
    for (int j = 0; j < 12; ++j) sq[h * 96 + sub + 8 * j] = kk[j];
    wave_lds_sync();
    {
      *(uint4*)(Kb + (size_t)t * 768 + lane * 8) = pack8(sq + lane * 8);
      if (lane < 32) *(uint4*)(Kb + (size_t)t * 768 + (lane + 64) * 8) = pack8(sq + (lane + 64) * 8);
    }
    if (lane & 8) {
      unpack8(kv0, f);
#pragma unroll
      for (int j = 0; j < 8; ++j) f[j] *= rkv;
      *(uint4*)(KV + (size_t)t * 1024 + lane * 8) = pack8(f);
      unpack8(kv1, f);
#pragma unroll
      for (int j = 0; j < 8; ++j) f[j] *= rkv;
      *(uint4*)(KV + (size_t)t * 1024 + (lane + 64) * 8) = pack8(f);
    }
    wave_lds_sync();
  }
}

DI void swa_finalize(const P& p, char* smem, int vb, int nvb) {
  const int tid_ = get_tid();
  const int lane = tid_ & 63, wave = tid_ >> 6;
  const u16* z = (const u16*)(p.ws + OFF_REGB);
  u16* Q = (u16*)(p.ws + OFF_QB);
  u16* Kb = (u16*)(p.ws + OFF_KB);
  const int sub = lane & 7;
  const float SSCALE = 0.125f * LOG2E;
  float qn[8], kn[8];
#pragma unroll
  for (int j = 0; j < 8; ++j) { qn[j] = p.od_q_norm[sub * 8 + j]; kn[j] = p.od_k_norm[sub * 8 + j]; }
  const float* side = (const float*)(p.ws + OFF_SIDE);
  float* alpha0 = (float*)(p.ws + OFF_KB + (size_t)T * 128 * 2);
  float* alpha1 = (float*)(p.ws + OFF_REGA + (size_t)LAT * 512 * 2);
  float* w2s = (float*)smem;
  float* gbs = w2s + 8192;
  float* sds = gbs + 512 + wave * 32;
  __syncthreads();
  for (int i = tid_; i < 8192; i += NTHR) w2s[i] = p.od_w2[i];
  for (int i = tid_; i < 512; i += NTHR) gbs[i] = p.od_gb[i];
  __syncthreads();
  for (int t = vb * 4 + wave; t < T; t += nvb * 4) {
    if (lane < 32) sds[lane] = side[(size_t)t * 32 + lane];
    wave_lds_sync();
#pragma unroll
    for (int dr = 0; dr < 2; ++dr) {
      f32x4v lg = *(const f32x4v*)(gbs + dr * 256 + lane * 4);
#pragma unroll
      for (int r4 = 0; r4 < 4; ++r4) {
        const f32x4v zg = *(const f32x4v*)(sds + dr * 16 + r4 * 4);
        lg += *(const f32x4v*)(w2s + (dr * 16 + r4 * 4 + 0) * 256 + lane * 4) * zg.x;
        lg += *(const f32x4v*)(w2s + (dr * 16 + r4 * 4 + 1) * 256 + lane * 4) * zg.y;
        lg += *(const f32x4v*)(w2s + (dr * 16 + r4 * 4 + 2) * 256 + lane * 4) * zg.z;
        lg += *(const f32x4v*)(w2s + (dr * 16 + r4 * 4 + 3) * 256 + lane * 4) * zg.w;
      }
      f32x4v al;
      al.x = __expf((fminf(lg.x, 0.f) - __logf(1.f + __expf(-fabsf(lg.x)))) * (1.f / 16.f));
      al.y = __expf((fminf(lg.y, 0.f) - __logf(1.f + __expf(-fabsf(lg.y)))) * (1.f / 16.f));
      al.z = __expf((fminf(lg.z, 0.f) - __logf(1.f + __expf(-fabsf(lg.z)))) * (1.f / 16.f));
      al.w = __expf((fminf(lg.w, 0.f) - __logf(1.f + __expf(-fabsf(lg.w)))) * (1.f / 16.f));
      *(f32x4v*)((dr == 0 ? alpha0 : alpha1) + (size_t)t * 256 + lane * 4) = al;
    }
    wave_lds_sync();
    const bool lat = t < LAT;
    const int pos = t & 2047;
    float cs = 1.f, sn = 0.f;
    if (lat) {
      const int fi = lane & 15;
      const float inv = exp2f(-(float)fi * (13.287712379549449f / 16.f));
      const float pc = (lane & 16) ? (float)(pos & 63) : (float)(pos >> 6);
      float rev = pc * inv * 0.15915494309189535f;
      rev -= floorf(rev);
      cs = __builtin_amdgcn_cosf(rev);
      sn = __builtin_amdgcn_sinf(rev);
    }
    float cj[8], sj[8];
#pragma unroll
    for (int j = 0; j < 8; ++j) { cj[j] = __shfl(cs, (sub & 3) * 8 + j); sj[j] = __shfl(sn, (sub & 3) * 8 + j); }
    float f[8];
    if (lat) {
      uint4 v = *(const uint4*)(z + (size_t)t * ODD_IN + 1568 + lane * 8);
      unpack8(v, f);
      float ss = 0.f;
#pragma unroll
      for (int j = 0; j < 8; ++j) ss += f[j] * f[j];
      ss += __shfl_xor(ss, 1); ss += __shfl_xor(ss, 2); ss += __shfl_xor(ss, 4);
      const float rms = rsqrtf(ss * (1.f / 64.f) + EPS);
#pragma unroll
      for (int j = 0; j < 8; ++j) {
        const float yv = f[j] * rms * qn[j];
        const float pv = __shfl_xor(yv, 4);
        const float o = (sub < 4) ? (yv * cj[j] - pv * sj[j]) : (pv * sj[j] + yv * cj[j]);
        f[j] = o * SSCALE;
      }
      *(uint4*)(Q + (size_t)t * 512 + lane * 8) = pack8(f);
    }
    {
      const int l16 = lane & 15;
      uint4 v = *(const uint4*)(z + (size_t)t * ODD_IN + 2080 + l16 * 8);
      unpack8(v, f);
      float ss = 0.f;
#pragma unroll
      for (int j = 0; j < 8; ++j) ss += f[j] * f[j];
      ss += __shfl_xor(ss, 1); ss += __shfl_xor(ss, 2); ss += __shfl_xor(ss, 4);
      const float rms = rsqrtf(ss * (1.f / 64.f) + EPS);
#pragma unroll
      for (int j = 0; j < 8; ++j) {
        const float yv = f[j] * rms * kn[j];
        const float pv = __shfl_xor(yv, 4);
        float o = yv;
        if (lat) o = (sub < 4) ? (yv * cj[j] - pv * sj[j]) : (pv * sj[j] + yv * cj[j]);
        f[j] = o;
      }
      if (lane < 16) *(uint4*)(Kb + (size_t)t * 128 + lane * 8) = pack8(f);
    }
  }
}

template <int DQK, bool SWA>
DI void attn_item(const u16* __restrict__ Q, int ldq, int qoff, const u16* __restrict__ Kp, int ldk, int koff,
                  const u16* __restrict__ Vp, int ldv, int voff, int qrow0, int qpos0, int crow0, int lrow0, int kt_lo,
                  int kt_hi, float sink2, u16* __restrict__ O, int ldo, int ooff, char* smem) {
  constexpr int KSTR = DQK + 8, VSTR = 72, CPR = DQK / 8, NKC = 64 * CPR / 256, NKS = DQK / 16;
  u16* Ks = (u16*)smem;
  u16* Vt = Ks + 2 * 64 * KSTR;
  const int tid = get_tid(), lane = tid & 63, wave = tid >> 6, r = lane & 31, hh = lane >> 5;
  const int nt = 4 + (kt_hi - kt_lo);
  bf16x8 bq[NKS];
  {
    const u16* qp = Q + (size_t)(qrow0 + wave * 32 + r) * ldq + qoff + hh * 8;
#pragma unroll
    for (int ks = 0; ks < NKS; ++ks) bq[ks] = *(const bf16x8*)(qp + ks * 16);
  }
  u32x4 rk[NKC], rv[2];
#define A_LOADG(IT)                                                                                   \
  {                                                                                                   \
    const int i_ = (IT);                                                                              \
    const int base_ = i_ < 4 ? crow0 + i_ * 64 : lrow0 + (kt_lo + i_ - 4) * 64;                       \
    _Pragma("unroll") for (int j = 0; j < NKC; ++j) {                                                 \
      const int c = tid + 256 * j, row = c / CPR, kc = c % CPR;                                       \
      rk[j] = *(const u32x4*)(Kp + (size_t)(base_ + row) * ldk + koff + kc * 8);                      \
    }                                                                                                 \
    _Pragma("unroll") for (int j = 0; j < 2; ++j) {                                                   \
      const int c = tid + 256 * j, row = c >> 3, dc = c & 7;                                          \
      rv[j] = *(const u32x4*)(Vp + (size_t)(base_ + row) * ldv + voff + dc * 8);                      \
    }                                                                                                 \
  }
#define A_STORES(BUF)                                                                                 \
  {                                                                                                   \
    const int buf_ = (BUF);                                                                           \
    _Pragma("unroll") for (int j = 0; j < NKC; ++j) {                                                 \
      const int c = tid + 256 * j, row = c / CPR, kc = c % CPR;                                       \
      *(u32x4*)(Ks + buf_ * 64 * KSTR + row * KSTR + kc * 8) = rk[j];                                 \
    }                                                                                                 \
    _Pragma("unroll") for (int j = 0; j < 2; ++j) {                                                   \
      const int c = tid + 256 * j, key = c >> 3, dc = c & 7;                                          \
      u16* vb = Vt + buf_ * 64 * VSTR + (dc * 8) * VSTR + key;                                        \
      const unsigned w0 = rv[j].x, w1 = rv[j].y, w2 = rv[j].z, w3 = rv[j].w;                          \
      vb[0 * VSTR] = (u16)(w0 & 0xffff); vb[1 * VSTR] = (u16)(w0 >> 16);                              \
      vb[2 * VSTR] = (u16)(w1 & 0xffff); vb[3 * VSTR] = (u16)(w1 >> 16);                              \
      vb[4 * VSTR] = (u16)(w2 & 0xffff); vb[5 * VSTR] = (u16)(w2 >> 16);                              \
      vb[6 * VSTR] = (u16)(w3 & 0xffff); vb[7 * VSTR] = (u16)(w3 >> 16);                              \
    }                                                                                                 \
  }
  f32x16 o[2];
#pragma unroll
  for (int a = 0; a < 2; ++a)
#pragma unroll
    for (int i = 0; i < 16; ++i) o[a][i] = 0.f;
  float m = -INFINITY, lsum = 0.f;
  A_LOADG(0);
  A_STORES(0);
  __syncthreads();
  for (int it = 0; it < nt; ++it) {
    const int buf = it & 1;
    if (it + 1 < nt) A_LOADG(it + 1);
    f32x16 s[2];
#pragma unroll
    for (int mt = 0; mt < 2; ++mt) {
#pragma unroll
      for (int i = 0; i < 16; ++i) s[mt][i] = 0.f;
      const u16* kb = Ks + buf * 64 * KSTR + (mt * 32 + r) * KSTR + hh * 8;
#pragma unroll
      for (int ks = 0; ks < NKS; ++ks) {
        const bf16x8 a = *(const bf16x8*)(kb + ks * 16);
        s[mt] = MFMA(a, bq[ks], s[mt]);
      }
    }
    if (SWA && it >= 4) {
      const int kpos0 = (kt_lo + it - 4) * 64;
      const int qpos = qpos0 + wave * 32 + r;
#pragma unroll
      for (int mt = 0; mt < 2; ++mt)
#pragma unroll
        for (int i = 0; i < 16; ++i) {
          const int kpos = kpos0 + mt * 32 + (i & 3) + 8 * (i >> 2) + 4 * hh;
          const int dlt = kpos - qpos;
          if (dlt > 128 || dlt < -128) s[mt][i] = -INFINITY;
        }
    }
    float mx = -INFINITY;
#pragma unroll
    for (int mt = 0; mt < 2; ++mt)
#pragma unroll
      for (int i = 0; i < 16; ++i) mx = fmaxf(mx, s[mt][i]);
    mx = fmaxf(mx, __shfl_xor(mx, 32));
    const float mnew = fmaxf(m, mx);
    const float alpha = __builtin_amdgcn_exp2f(m - mnew);
    m = mnew;
    float psum = 0.f;
#pragma unroll
    for (int mt = 0; mt < 2; ++mt)
#pragma unroll
      for (int i = 0; i < 16; ++i) {
        const float pv = __builtin_amdgcn_exp2f(s[mt][i] - mnew);
        s[mt][i] = pv;
        psum += pv;
      }
    lsum = lsum * alpha + psum;
#pragma unroll
    for (int a = 0; a < 2; ++a)
#pragma unroll
      for (int i = 0; i < 16; ++i) o[a][i] *= alpha;
#pragma unroll
    for (int mt = 0; mt < 2; ++mt)
#pragma unroll
      for (int sx = 0; sx < 2; ++sx) {
        uint4 pu;
        pu.x = pack2(s[mt][8 * sx + 0], s[mt][8 * sx + 1]);
        pu.y = pack2(s[mt][8 * sx + 2], s[mt][8 * sx + 3]);
        pu.z = pack2(s[mt][8 * sx + 4], s[mt][8 * sx + 5]);
        pu.w = pack2(s[mt][8 * sx + 6], s[mt][8 * sx + 7]);
        const bf16x8 pfv = __builtin_bit_cast(bf16x8, pu);
#pragma unroll
        for (int dt = 0; dt < 2; ++dt) {
          const u16* vp = Vt + buf * 64 * VSTR + (dt * 32 + r) * VSTR + mt * 32 + 16 * sx + 4 * hh;
          const uint2 v0 = *(const uint2*)(vp);
          const uint2 v1 = *(const uint2*)(vp + 8);
          const uint4 vu = make_uint4(v0.x, v0.y, v1.x, v1.y);
          o[dt] = MFMA(__builtin_bit_cast(bf16x8, vu), pfv, o[dt]);
        }
      }
    if (it + 1 < nt) A_STORES(buf ^ 1);
    __syncthreads();
  }
  float l = lsum + __shfl_xor(lsum, 32);
  if (SWA) l += __builtin_amdgcn_exp2f(sink2 - m);
  const float inv = 1.f / l;
  u16* op = O + (size_t)(qrow0 + wave * 32 + r) * ldo + ooff;
#pragma unroll
  for (int dt = 0; dt < 2; ++dt)
#pragma unroll
    for (int g4 = 0; g4 < 4; ++g4) {
      uint2 w;
      w.x = pack2(o[dt][4 * g4 + 0] * inv, o[dt][4 * g4 + 1] * inv);
      w.y = pack2(o[dt][4 * g4 + 2] * inv, o[dt][4 * g4 + 3] * inv);
      *(uint2*)(op + dt * 32 + 8 * g4 + 4 * hh) = w;
    }
}

DI void gdn_chain(const P& p, int cid, char* smem) {
  const int eb = cid & 1, chn = cid >> 1;
  const int dir = chn >> 6, b = (chn >> 3) & 7, h = chn & 7;
  float* qs = (float*)smem;
  float* ks = qs + 4096;
  float* vs = ks + 4096;
  float* ob = vs + 2048;
  float* ps = ob + 2048;
  float* cw = ps + 256;
  const int tid = get_tid(), lane = tid & 63, wave = tid >> 6;
  const u16* z = (const u16*)(p.ws + OFF_REGB);
  const float* side = (const float*)(p.ws + OFF_SIDE);
  u16* od = (u16*)(p.ws + OFF_ODIR) + (size_t)dir * T * 512;
  __syncthreads();
  for (int i = tid; i < 800; i += NTHR) {
    const int j = i / 160, cc = i % 160;
    const int chi = cc < 64 ? h * 64 + cc : (cc < 128 ? 512 + h * 64 + (cc - 64) : 1024 + h * 64 + eb * 32 + (cc - 128));
    cw[i] = p.ev_conv[j * 1536 + chi];
  }
  const float Aexp = __expf(p.ev_a_log[dir * 8 + h]);
  const float dtb = p.ev_dt_bias[dir * 8 + h];
  __builtin_amdgcn_s_setprio(3);
  f32x2 S[4];
#pragma unroll
  for (int i = 0; i < 4; ++i) S[i] = (f32x2){0.f, 0.f};
  const int dl = lane & 7, ec = wave * 8 + (lane >> 3);
  const int pp = tid >> 2, qd = tid & 3;
  __syncthreads();
  for (int seg = 0; seg < 2; ++seg) {
    const int len = seg == 0 ? CTXL : SEQ;
    const int base = seg == 0 ? LAT + b * CTXL : b * SEQ;
    for (int c = 0; c < len / 64; ++c) {
      {
        const int pos = c * 64 + pp;
        const int tau = dir ? len - 1 - pos : pos;
        float aq[16], ak[16], av[8];
#pragma unroll
        for (int i = 0; i < 16; ++i) { aq[i] = 0.f; ak[i] = 0.f; }
#pragma unroll
        for (int i = 0; i < 8; ++i) av[i] = 0.f;
#pragma unroll
        for (int j = 0; j < 5; ++j) {
          const int tt = tau + j - 2;
          if (tt >= 0 && tt < len) {
            const u16* zr = z + (size_t)(base + tt) * EVEN_IN + h * 64;
            float f[16];
            unpack8(*(const uint4*)(zr + 672 + qd * 16), f); unpack8(*(const uint4*)(zr + 672 + qd * 16 + 8), f + 8);
#pragma unroll
            for (int i = 0; i < 16; ++i) aq[i] += cw[j * 160 + qd * 16 + i] * f[i];
            unpack8(*(const uint4*)(zr + 1184 + qd * 16), f); unpack8(*(const uint4*)(zr + 1184 + qd * 16 + 8), f + 8);
#pragma unroll
            for (int i = 0; i < 16; ++i) ak[i] += cw[j * 160 + 64 + qd * 16 + i] * f[i];
            unpack8(*(const uint4*)(zr + 1696 + eb * 32 + qd * 8), f);
#pragma unroll
            for (int i = 0; i < 8; ++i) av[i] += cw[j * 160 + 128 + qd * 8 + i] * f[i];
          }
        }
        float sq2 = 0.f, sk2 = 0.f;
#pragma unroll
        for (int i = 0; i < 16; ++i) {
          aq[i] = silu_f(aq[i]); ak[i] = silu_f(ak[i]);
          sq2 += aq[i] * aq[i]; sk2 += ak[i] * ak[i];
        }
        sq2 = quad_sum(sq2);
        sk2 = quad_sum(sk2);
        const float rq = rsqrtf(sq2 + EPS) * 0.125f, rk = rsqrtf(sk2 + EPS);
#pragma unroll
        for (int i = 0; i < 16; ++i) { aq[i] *= rq; ak[i] *= rk; }
#pragma unroll
        for (int i = 0; i < 4; ++i) {
          *(float4*)(qs + pp * 64 + qd * 16 + i * 4) = make_float4(aq[4 * i], aq[4 * i + 1], aq[4 * i + 2], aq[4 * i + 3]);
          *(float4*)(ks + pp * 64 + qd * 16 + i * 4) = make_float4(ak[4 * i], ak[4 * i + 1], ak[4 * i + 2], ak[4 * i + 3]);
        }
        *(float4*)(vs + pp * 32 + qd * 8) = make_float4(silu_f(av[0]), silu_f(av[1]), silu_f(av[2]), silu_f(av[3]));
        *(float4*)(vs + pp * 32 + qd * 8 + 4) = make_float4(silu_f(av[4]), silu_f(av[5]), silu_f(av[6]), silu_f(av[7]));
        float gsame = 0.f, kk = 0.f, g21 = 0.f;
#pragma unroll
        for (int i = 0; i < 16; ++i) {
          const float kp = __builtin_bit_cast(float, __builtin_amdgcn_mov_dpp(__builtin_bit_cast(int, ak[i]), 0x114, 0xF, 0xF, true));
          gsame += aq[i] * ak[i];
          kk += kp * ak[i];
          g21 += aq[i] * kp;
        }
        gsame = quad_sum(gsame);
        kk = quad_sum(kk);
        g21 = quad_sum(g21);
        if (qd == 0) {
          const float za = side[(size_t)(base + tau) * 32 + dir * 8 + h];
          const float zb = side[(size_t)(base + tau) * 32 + 16 + dir * 8 + h];
          const float av_ = __expf(-Aexp * softplus_f(za + dtb));
          const float bv_ = sigmoid_f(zb);
          float* pr = ps + (pp >> 1) * 8;
          if (pp & 1) { pr[2] = av_; pr[3] = bv_; pr[4] = kk; pr[6] = g21; pr[7] = gsame; }
          else { pr[0] = av_; pr[1] = bv_; pr[5] = gsame; }
        }
      }
      __syncthreads();
#define GDN_LOAD2(M, X)                                                                     \
  X##k1a = *(const f32x4v*)(ks + (2 * (M)) * 64 + dl * 8); X##k1b = *(const f32x4v*)(ks + (2 * (M)) * 64 + dl * 8 + 4);         \
  X##k2a = *(const f32x4v*)(ks + (2 * (M) + 1) * 64 + dl * 8); X##k2b = *(const f32x4v*)(ks + (2 * (M) + 1) * 64 + dl * 8 + 4); \
  X##q1a = *(const f32x4v*)(qs + (2 * (M)) * 64 + dl * 8); X##q1b = *(const f32x4v*)(qs + (2 * (M)) * 64 + dl * 8 + 4);         \
  X##q2a = *(const f32x4v*)(qs + (2 * (M) + 1) * 64 + dl * 8); X##q2b = *(const f32x4v*)(qs + (2 * (M) + 1) * 64 + dl * 8 + 4); \
  X##v1 = vs[(2 * (M)) * 32 + ec]; X##v2 = vs[(2 * (M) + 1) * 32 + ec];                      \
  X##s0 = *(const f32x4v*)(ps + (M) * 8); X##s1 = *(const f32x4v*)(ps + (M) * 8 + 4);        \
  __builtin_amdgcn_sched_barrier(0);
#define GDN_DOT(VA, VB, OUT)                                                                \
  {                                                                                         \
    f32x2 d_ = VA.xy * S[0] + VA.zw * S[1];                                                 \
    d_ += VB.xy * S[2] + VB.zw * S[3];                                                      \
    OUT = d_.x + d_.y;                                                                      \
  }
#define GDN_STEP2(U, X)                                                                     \
  {                                                                                         \
    const float a1 = X##s0.x, b1 = X##s0.y, a2 = X##s0.z, b2 = X##s0.w;                     \
    const float kk = X##s1.x, g11 = X##s1.y, g21 = X##s1.z, g22 = X##s1.w;                  \
    float p1, p2, r1, r2;                                                                   \
    GDN_DOT(X##k1a, X##k1b, p1) GDN_DOT(X##k2a, X##k2b, p2)                                 \
    GDN_DOT(X##q1a, X##q1b, r1) GDN_DOT(X##q2a, X##q2b, r2)                                 \
    p1 = row8_sum(p1); p2 = row8_sum(p2); r1 = row8_sum(r1); r2 = row8_sum(r2);             \
    const float c1 = b1 * (X##v1 - a1 * p1);                                                \
    const float o1 = a1 * r1 + g11 * c1;                                                    \
    const float c2 = b2 * (X##v2 - a2 * (a1 * p2 + kk * c1));                               \
    const float o2 = a2 * (a1 * r2 + g21 * c1) + g22 * c2;                                  \
    const float a21 = a2 * a1, w1 = a2 * c1;                                                \
    const f32x2 A2 = (f32x2){a21, a21}, W1 = (f32x2){w1, w1}, C2 = (f32x2){c2, c2};          \
    S[0] = A2 * S[0] + X##k1a.xy * W1 + X##k2a.xy * C2;                                     \
    S[1] = A2 * S[1] + X##k1a.zw * W1 + X##k2a.zw * C2;                                     \
    S[2] = A2 * S[2] + X##k1b.xy * W1 + X##k2b.xy * C2;                                     \
    S[3] = A2 * S[3] + X##k1b.zw * W1 + X##k2b.zw * C2;                                     \
    myo = (dl == 2 * (U)) ? o1 : myo;                                                       \
    myo = (dl == 2 * (U) + 1) ? o2 : myo;                                                   \
    __builtin_amdgcn_sched_barrier(0);                                                      \
  }
      f32x4v Ak1a, Ak1b, Ak2a, Ak2b, Aq1a, Aq1b, Aq2a, Aq2b, As0, As1;
      f32x4v Bk1a, Bk1b, Bk2a, Bk2b, Bq1a, Bq1b, Bq2a, Bq2b, Bs0, Bs1;
      float Av1, Av2, Bv1, Bv2;
      GDN_LOAD2(0, A)
      for (int t0 = 0; t0 < 64; t0 += 8) {
        float myo = 0.f;
        const int m0 = t0 >> 1;
        GDN_LOAD2(m0 + 1, B) GDN_STEP2(0, A)
        GDN_LOAD2(m0 + 2, A) GDN_STEP2(1, B)
        GDN_LOAD2(m0 + 3, B) GDN_STEP2(2, A)
        GDN_LOAD2(m0 + 4, A) GDN_STEP2(3, B)
        const int pos = c * 64 + t0 + dl;
        const int tau = dir ? len - 1 - pos : pos;
        od[(size_t)(base + tau) * 512 + h * 64 + eb * 32 + ec] = f2bf(myo);
      }
      __syncthreads();
    }
  }
  __builtin_amdgcn_s_setprio(0);
}

DI void gla_chain(const P& p, int cid, char* smem) {
  const int e4 = cid & 3, chn = cid >> 2;
  const int dir = chn >> 5, b = (chn >> 2) & 7, h = chn & 3;
  float* qs = (float*)smem;
  float* ks = qs + 4096;
  float* as = ks + 4096;
  float* vs = as + 4096;
  float* ob = vs + 2048;
  const int tid = get_tid(), lane = tid & 63, wave = tid >> 6;
  const u16* z = (const u16*)(p.ws + OFF_REGB);
  const float* alpha = dir == 0 ? (const float*)(p.ws + OFF_KB + (size_t)T * 128 * 2)
                                : (const float*)(p.ws + OFF_REGA + (size_t)LAT * 512 * 2);
  u16* od = (u16*)(p.ws + OFF_ODIR) + (size_t)dir * T * 512;
  __builtin_amdgcn_s_setprio(3);
  f32x2 S[4];
#pragma unroll
  for (int i = 0; i < 4; ++i) S[i] = (f32x2){0.f, 0.f};
  const int dl = lane & 7, ec = wave * 8 + (lane >> 3);
  const int pp = tid >> 2, qd = tid & 3;
  __syncthreads();
  for (int seg = 0; seg < 2; ++seg) {
    const int len = seg == 0 ? CTXL : SEQ;
    const int base = seg == 0 ? LAT + b * CTXL : b * SEQ;
    for (int c = 0; c < len / 64; ++c) {
      {
        const int pos = c * 64 + pp;
        const int tau = dir ? len - 1 - pos : pos;
        const u16* zr = z + (size_t)(base + tau) * ODD_IN;
        float f[16];
        unpack8(*(const uint4*)(zr + h * 64 + qd * 16), f); unpack8(*(const uint4*)(zr + h * 64 + qd * 16 + 8), f + 8);
#pragma unroll
        for (int i = 0; i < 4; ++i)
          *(float4*)(qs + pp * 64 + qd * 16 + i * 4) =
              make_float4(f[4 * i] * 0.125f, f[4 * i + 1] * 0.125f, f[4 * i + 2] * 0.125f, f[4 * i + 3] * 0.125f);
        unpack8(*(const uint4*)(zr + 256 + h * 64 + qd * 16), f); unpack8(*(const uint4*)(zr + 256 + h * 64 + qd * 16 + 8), f + 8);
#pragma unroll
        for (int i = 0; i < 4; ++i)
          *(float4*)(ks + pp * 64 + qd * 16 + i * 4) = make_float4(f[4 * i], f[4 * i + 1], f[4 * i + 2], f[4 * i + 3]);
        const float* ar = alpha + (size_t)(base + tau) * 256 + h * 64 + qd * 16;
#pragma unroll
        for (int i = 0; i < 4; ++i) *(float4*)(as + pp * 64 + qd * 16 + i * 4) = *(const float4*)(ar + i * 4);
        unpack8(*(const uint4*)(zr + 512 + h * 128 + e4 * 32 + qd * 8), f);
        *(float4*)(vs + pp * 32 + qd * 8) = make_float4(f[0], f[1], f[2], f[3]);
        *(float4*)(vs + pp * 32 + qd * 8 + 4) = make_float4(f[4], f[5], f[6], f[7]);
      }
      __syncthreads();
      if (seg == 0) {
#pragma unroll 4
        for (int t = 0; t < 64; ++t) {
          const f32x4v ka = *(const f32x4v*)(ks + t * 64 + dl * 8), kb = *(const f32x4v*)(ks + t * 64 + dl * 8 + 4);
          const f32x4v aa = *(const f32x4v*)(as + t * 64 + dl * 8), ab = *(const f32x4v*)(as + t * 64 + dl * 8 + 4);
          const float v = vs[t * 32 + ec];
          const f32x2 v2 = (f32x2){v, v};
          S[0] = aa.xy * S[0] + ka.xy * v2; S[1] = aa.zw * S[1] + ka.zw * v2;
          S[2] = ab.xy * S[2] + kb.xy * v2; S[3] = ab.zw * S[3] + kb.zw * v2;
        }
        __syncthreads();
      } else {
#define GLA_LOAD(TT, X)                                                                     \
  X##ka = *(const f32x4v*)(ks + (TT) * 64 + dl * 8); X##kb = *(const f32x4v*)(ks + (TT) * 64 + dl * 8 + 4); \
  X##qa = *(const f32x4v*)(qs + (TT) * 64 + dl * 8); X##qb = *(const f32x4v*)(qs + (TT) * 64 + dl * 8 + 4); \
  X##aa = *(const f32x4v*)(as + (TT) * 64 + dl * 8); X##ab = *(const f32x4v*)(as + (TT) * 64 + dl * 8 + 4); \
  X##v = vs[(TT) * 32 + ec];                                                                \
  __builtin_amdgcn_sched_barrier(0);
#define GLA_STEP(U, X)                                                                      \
  {                                                                                         \
    const f32x2 v2 = (f32x2){X##v, X##v};                                                   \
    S[0] = X##aa.xy * S[0] + X##ka.xy * v2; S[1] = X##aa.zw * S[1] + X##ka.zw * v2;         \
    S[2] = X##ab.xy * S[2] + X##kb.xy * v2; S[3] = X##ab.zw * S[3] + X##kb.zw * v2;         \
    f32x2 orr = X##qa.xy * S[0] + X##qa.zw * S[1];                                          \
    orr += X##qb.xy * S[2] + X##qb.zw * S[3];                                               \
    const float ov = row8_sum(orr.x + orr.y);                                               \
    myo = (dl == (U)) ? ov : myo;                                                           \
    __builtin_amdgcn_sched_barrier(0);                                                      \
  }
        f32x4v Aka, Akb, Aqa, Aqb, Aaa, Aab, Bka, Bkb, Bqa, Bqb, Baa, Bab;
        float Av, Bv;
        GLA_LOAD(0, A)
        for (int t0 = 0; t0 < 64; t0 += 8) {
          float myo = 0.f;
          GLA_LOAD(t0 + 1, B) GLA_STEP(0, A)
          GLA_LOAD(t0 + 2, A) GLA_STEP(1, B)
          GLA_LOAD(t0 + 3, B) GLA_STEP(2, A)
          GLA_LOAD(t0 + 4, A) GLA_STEP(3, B)
          GLA_LOAD(t0 + 5, B) GLA_STEP(4, A)
          GLA_LOAD(t0 + 6, A) GLA_STEP(5, B)
          GLA_LOAD(t0 + 7, B) GLA_STEP(6, A)
          GLA_LOAD(t0 + 8, A) GLA_STEP(7, B)
          const int pos = c * 64 + t0 + dl;
          const int tau = dir ? len - 1 - pos : pos;
          od[(size_t)(base + tau) * 512 + h * 128 + e4 * 32 + ec] = f2bf(myo);
        }
        __syncthreads();
      }
    }
  }
  __builtin_amdgcn_s_setprio(0);
}

DI void gla_chain_mfma(const P& p, int cid, char* smem) {
  const int eh = cid & 1, chn = cid >> 1;
  const int dir = chn >> 5, b = (chn >> 2) & 7, h = chn & 3;
  u16* QD = (u16*)smem;
  u16* KI = QD + 64 * 72;
  u16* KDT = KI + 64 * 72;
  u16* VT = KDT + 64 * 72;
  u16* ST = VT + 64 * 72;
  float* BC = (float*)(ST + 64 * 72);
  const int tid = get_tid(), lane = tid & 63, wave = tid >> 6, r = lane & 31, hh = lane >> 5;
  const int et = wave >> 1, it = wave & 1;
  const int pp = tid >> 2, q4 = tid & 3;
  const u16* z = (const u16*)(p.ws + OFF_REGB);
  const float* alpha = dir == 0 ? (const float*)(p.ws + OFF_KB + (size_t)T * 128 * 2)
                                : (const float*)(p.ws + OFF_REGA + (size_t)LAT * 512 * 2);
  u16* od = (u16*)(p.ws + OFF_ODIR) + (size_t)dir * T * 512;
  __syncthreads();
  for (int i = tid; i < 64 * 72 / 2; i += NTHR) ((unsigned*)ST)[i] = 0u;
  f32x16 Sreg;
#pragma unroll
  for (int i = 0; i < 16; ++i) Sreg[i] = 0.f;
  __syncthreads();
  u32x4 rq0, rq1, rk0, rk1, rv0, rv1;
  f32x4v ra0, ra1, ra2, ra3;
#define GLM_RAW(G)                                                                                    \
  {                                                                                                   \
    const int g_ = (G);                                                                               \
    const int sg_ = g_ < 4 ? 0 : 1, c_ = sg_ ? g_ - 4 : g_;                                           \
    const int len_ = sg_ ? SEQ : CTXL, base_ = sg_ ? b * SEQ : LAT + b * CTXL;                        \
    const int pos_ = c_ * 64 + pp;                                                                    \
    const int tau_ = dir ? len_ - 1 - pos_ : pos_;                                                    \
    const u16* zr_ = z + (size_t)(base_ + tau_) * ODD_IN;                                             \
    rq0 = *(const u32x4*)(zr_ + h * 64 + q4 * 16); rq1 = *(const u32x4*)(zr_ + h * 64 + q4 * 16 + 8); \
    rk0 = *(const u32x4*)(zr_ + 256 + h * 64 + q4 * 16); rk1 = *(const u32x4*)(zr_ + 256 + h * 64 + q4 * 16 + 8); \
    rv0 = *(const u32x4*)(zr_ + 512 + h * 128 + eh * 64 + q4 * 16);                                   \
    rv1 = *(const u32x4*)(zr_ + 512 + h * 128 + eh * 64 + q4 * 16 + 8);                               \
    const float* ar_ = alpha + (size_t)(base_ + tau_) * 256 + h * 64 + q4 * 16;                       \
    ra0 = *(const f32x4v*)(ar_); ra1 = *(const f32x4v*)(ar_ + 4); ra2 = *(const f32x4v*)(ar_ + 8); ra3 = *(const f32x4v*)(ar_ + 12); \
  }
  GLM_RAW(0)
  {
    for (int gidx = 0; gidx < 36; ++gidx) {
      const int seg = gidx < 4 ? 0 : 1, c = seg ? gidx - 4 : gidx;
      const int len = seg ? SEQ : CTXL;
      const int base = seg ? b * SEQ : LAT + b * CTXL;
      float qf[16], kf[16];
      {
        unpack8v(rq0, qf); unpack8v(rq1, qf + 8);
        unpack8v(rk0, kf); unpack8v(rk1, kf + 8);
        const f32x4v al[4] = {ra0, ra1, ra2, ra3};
#pragma unroll
        for (int i = 0; i < 4; ++i) {
          BC[pp * 65 + q4 * 16 + i * 4 + 0] = __logf(al[i].x); BC[pp * 65 + q4 * 16 + i * 4 + 1] = __logf(al[i].y);
          BC[pp * 65 + q4 * 16 + i * 4 + 2] = __logf(al[i].z); BC[pp * 65 + q4 * 16 + i * 4 + 3] = __logf(al[i].w);
        }
        const unsigned vw[8] = {rv0.x, rv0.y, rv0.z, rv0.w, rv1.x, rv1.y, rv1.z, rv1.w};
#pragma unroll
        for (int i = 0; i < 8; ++i) {
          VT[(q4 * 16 + 2 * i) * 72 + pp] = (u16)(vw[i] & 0xffffu);
          VT[(q4 * 16 + 2 * i + 1) * 72 + pp] = (u16)(vw[i] >> 16);
        }
        if (gidx + 1 < 36) GLM_RAW(gidx + 1)
      }
      __syncthreads();
      {
        float* PS4 = BC + 64 * 65;
        const int dcol = tid & 63, part = tid >> 6;
        float run = 0.f;
#pragma unroll
        for (int jj = 0; jj < 16; ++jj) { const int j = part * 16 + jj; run += BC[j * 65 + dcol]; BC[j * 65 + dcol] = run; }
        PS4[part * 64 + dcol] = run;
        __syncthreads();
        float off = 0.f;
        if (part > 0) off += PS4[dcol];
        if (part > 1) off += PS4[64 + dcol];
        if (part > 2) off += PS4[128 + dcol];
        if (part > 0) {
#pragma unroll
          for (int jj = 0; jj < 16; ++jj) BC[(part * 16 + jj) * 65 + dcol] += off;
        }
      }
      __syncthreads();
      {
        unsigned wq[8], wk[8];
#pragma unroll
        for (int i = 0; i < 8; ++i) {
          float qv[2], kv2[2];
#pragma unroll
          for (int u = 0; u < 2; ++u) {
            const int d = q4 * 16 + 2 * i + u;
            const float bcv = BC[pp * 65 + d], bl = BC[63 * 65 + d];
            const float e1 = __expf(bcv);
            qv[u] = qf[2 * i + u] * 0.125f * e1;
            kv2[u] = kf[2 * i + u] * __builtin_amdgcn_rcpf(e1);
            KDT[d * 72 + pp] = f2bf(kf[2 * i + u] * __expf(bl - bcv));
          }
          wq[i] = pack2(qv[0], qv[1]);
          wk[i] = pack2(kv2[0], kv2[1]);
        }
        *(u32x4*)(QD + pp * 72 + q4 * 16) = (u32x4){wq[0], wq[1], wq[2], wq[3]};
        *(u32x4*)(QD + pp * 72 + q4 * 16 + 8) = (u32x4){wq[4], wq[5], wq[6], wq[7]};
        *(u32x4*)(KI + pp * 72 + q4 * 16) = (u32x4){wk[0], wk[1], wk[2], wk[3]};
        *(u32x4*)(KI + pp * 72 + q4 * 16 + 8) = (u32x4){wk[4], wk[5], wk[6], wk[7]};
      }
      __syncthreads();
      if (seg == 1) {
        bf16x8 bqf[4];
#pragma unroll
        for (int ks = 0; ks < 4; ++ks) bqf[ks] = *(const bf16x8*)(QD + (it * 32 + r) * 72 + ks * 16 + hh * 8);
        f32x16 o;
#pragma unroll
        for (int i = 0; i < 16; ++i) o[i] = 0.f;
#pragma unroll
        for (int ks = 0; ks < 4; ++ks) {
          const bf16x8 a = *(const bf16x8*)(ST + (et * 32 + r) * 72 + ks * 16 + hh * 8);
          o = MFMA(a, bqf[ks], o);
        }
        for (int jt = 0; jt <= it; ++jt) {
          f32x16 sT;
#pragma unroll
          for (int i = 0; i < 16; ++i) sT[i] = 0.f;
#pragma unroll
          for (int ks = 0; ks < 4; ++ks) {
            const bf16x8 a = *(const bf16x8*)(KI + (jt * 32 + r) * 72 + ks * 16 + hh * 8);
            sT = MFMA(a, bqf[ks], sT);
          }
          if (jt == it) {
#pragma unroll
            for (int i = 0; i < 16; ++i) {
              const int jl = (i & 3) + 8 * (i >> 2) + 4 * hh;
              if (jl > r) sT[i] = 0.f;
            }
          }
#pragma unroll
          for (int sx = 0; sx < 2; ++sx) {
            u32x4 pu;
            pu.x = pack2(sT[8 * sx + 0], sT[8 * sx + 1]); pu.y = pack2(sT[8 * sx + 2], sT[8 * sx + 3]);
            pu.z = pack2(sT[8 * sx + 4], sT[8 * sx + 5]); pu.w = pack2(sT[8 * sx + 6], sT[8 * sx + 7]);
            const u16* vp = VT + (et * 32 + r) * 72 + jt * 32 + 16 * sx + 4 * hh;
            const uint2 va = *(const uint2*)(vp);
            const uint2 vb2 = *(const uint2*)(vp + 8);
            const u32x4 vu = {va.x, va.y, vb2.x, vb2.y};
            o = MFMA(__builtin_bit_cast(bf16x8, vu), __builtin_bit_cast(bf16x8, pu), o);
          }
        }
        const int pos = c * 64 + it * 32 + r;
        const int tau = dir ? len - 1 - pos : pos;
        u16* op = od + (size_t)(base + tau) * 512 + h * 128 + eh * 64 + et * 32;
#pragma unroll
        for (int g4 = 0; g4 < 4; ++g4) {
          uint2 w;
          w.x = pack2(o[4 * g4 + 0], o[4 * g4 + 1]);
          w.y = pack2(o[4 * g4 + 2], o[4 * g4 + 3]);
          *(uint2*)(op + 8 * g4 + 4 * hh) = w;
        }
      }
      {
        f32x16 kvt;
#pragma unroll
        for (int i = 0; i < 16; ++i) kvt[i] = 0.f;
#pragma unroll
        for (int ks = 0; ks < 4; ++ks) {
          const bf16x8 a = *(const bf16x8*)(VT + (et * 32 + r) * 72 + ks * 16 + hh * 8);
          const bf16x8 bk = *(const bf16x8*)(KDT + (it * 32 + r) * 72 + ks * 16 + hh * 8);
          kvt = MFMA(a, bk, kvt);
        }
        const float decay = __expf(BC[63 * 65 + it * 32 + r]);
#pragma unroll
        for (int i = 0; i < 16; ++i) Sreg[i] = Sreg[i] * decay + kvt[i];
      }
      __syncthreads();
#pragma unroll
      for (int i = 0; i < 16; ++i) {
        const int el = (i & 3) + 8 * (i >> 2) + 4 * hh;
        ST[(et * 32 + el) * 72 + it * 32 + r] = f2bf(Sreg[i]);
      }
    }
  }
}

DI void scan_post(const P& p, int layer, int vb, int nvb) {
  const int tid_ = get_tid();
  const int lane = tid_ & 63, wave = tid_ >> 6;
  const u16* z = (const u16*)(p.ws + OFF_REGB);
  u16* o0 = (u16*)(p.ws + OFF_ODIR);
  const u16* o1 = o0 + (size_t)T * 512;
  const int nrows = layer == 0 ? T : LAT;
  const int ldz = layer == 0 ? EVEN_IN : ODD_IN;
  const int goff = layer == 0 ? 2240 : 1056;
  float on[8];
#pragma unroll
  for (int j = 0; j < 8; ++j)
    on[j] = layer == 0 ? p.ev_out_norm[(lane & 7) * 8 + j] : p.od_out_norm[(lane & 15) * 8 + j];
  for (int t = vb * 4 + wave; t < nrows; t += nvb * 4) {
    float a[8], bb[8], gt[8];
    unpack8(*(const uint4*)(o0 + (size_t)t * 512 + lane * 8), a);
    unpack8(*(const uint4*)(o1 + (size_t)t * 512 + lane * 8), bb);
    unpack8(*(const uint4*)(z + (size_t)t * ldz + goff + lane * 8), gt);
    float ss = 0.f;
#pragma unroll
    for (int j = 0; j < 8; ++j) { a[j] += bb[j]; ss += a[j] * a[j]; }
    ss += __shfl_xor(ss, 1); ss += __shfl_xor(ss, 2); ss += __shfl_xor(ss, 4);
    float rms;
    if (layer == 0) rms = rsqrtf(ss * (1.f / 64.f) + EPS);
    else { ss += __shfl_xor(ss, 8); rms = rsqrtf(ss * (1.f / 128.f) + EPS); }
#pragma unroll
    for (int j = 0; j < 8; ++j) a[j] = a[j] * rms * on[j] * silu_f(gt[j]);
    *(uint4*)(o0 + (size_t)t * 512 + lane * 8) = pack8(a);
  }
}


#define XB_TMO      128
#define XB_XCNT(j)  (256  + 64 * (j))
#define XB_XSUB(j)  (1280 + 64 * (j))
#define XB_XGEN(j)  (2304 + 64 * (j))
#define XB_TOP      3328
#define XB_TOPGEN   3392
#define XB_SPIN_CAP (1u << 18)
#define LAS __attribute__((address_space(3)))
DI unsigned xb_ld(unsigned* p) { return __hip_atomic_load(p, __ATOMIC_RELAXED, __HIP_MEMORY_SCOPE_AGENT); }
DI unsigned xb_add(unsigned* p, unsigned v) { return __hip_atomic_fetch_add(p, v, __ATOMIC_RELAXED, __HIP_MEMORY_SCOPE_AGENT); }
DI unsigned xb_xcc_id() { return (unsigned)__builtin_amdgcn_s_getreg((3 << 11) | 20) & 0xFu; }
#define XB_SPIN(cond, bar) do { unsigned _sp = 0; while (cond) { __builtin_amdgcn_s_sleep(1); \
    if ((++_sp & 255u) == 0u) { if (xb_ld(&(bar)[XB_TMO])) break; if (_sp > XB_SPIN_CAP) { atomicAdd(&(bar)[XB_TMO], 1u); break; } } } } while (0)
struct XcdBarrier { unsigned* bar; unsigned x; unsigned G; unsigned nloc; unsigned nx; };
DI XcdBarrier xcd_barrier_post(unsigned* bar, unsigned G, bool member) {
  XcdBarrier b; b.bar = bar; b.x = xb_xcc_id(); b.G = G; b.nloc = 0u; b.nx = 0u;
  if (member && threadIdx.x == 0) (void)xb_add(&bar[XB_XCNT(b.x)], 1u);
  return b;
}
DI void xcd_barrier_complete(unsigned* bar, unsigned x, unsigned G, unsigned& nloc, unsigned& nx) {
  unsigned sum, cnt, mine, sp = 0u;
  for (;;) {
    sum = 0u; cnt = 0u; mine = 0u;
#pragma unroll
    for (unsigned j = 0; j < 16; ++j) { const unsigned c = xb_ld(&bar[XB_XCNT(j)]); sum += c; cnt += (c > 0u) ? 1u : 0u; mine = (j == x) ? c : mine; }
    if (sum == G) break;
    __builtin_amdgcn_s_sleep(1);
    if ((++sp & 255u) == 0u) { if (xb_ld(&bar[XB_TMO])) break; if (sp > XB_SPIN_CAP) { atomicAdd(&bar[XB_TMO], 1u); break; } }
  }
  nloc = mine > 0u ? mine : 1u; nx = cnt > 0u ? cnt : 1u;
}
DI void xcd_barrier(XcdBarrier& b) {
  asm volatile("s_waitcnt vmcnt(0)" ::: "memory");
  __syncthreads();
  if (threadIdx.x == 0) {
    unsigned* bar = b.bar;
    __builtin_amdgcn_s_waitcnt(0);
    unsigned nloc = b.nloc, nx = b.nx;
    if (nloc == 0u) { xcd_barrier_complete(bar, b.x, b.G, nloc, nx); b.nloc = nloc; b.nx = nx; }
    const unsigned old = xb_add(&bar[XB_XSUB(b.x)], 1u);
    const unsigned gen = old / nloc;
    if (old + 1u == (gen + 1u) * nloc) {
      __builtin_amdgcn_fence(__ATOMIC_RELEASE, "agent");
      asm volatile("s_waitcnt vmcnt(0)" ::: "memory");
      const unsigned og = xb_add(&bar[XB_TOP], 1u);
      const unsigned tg = og / nx;
      if (og + 1u == (tg + 1u) * nx) xb_add(&bar[XB_TOPGEN], 1u);
      else XB_SPIN(xb_ld(&bar[XB_TOPGEN]) == tg, bar);
      __builtin_amdgcn_fence(__ATOMIC_ACQUIRE, "agent");
      xb_add(&bar[XB_XGEN(b.x)], 1u);
      asm volatile("s_waitcnt vmcnt(0)" ::: "memory");
    } else {
      XB_SPIN(xb_ld(&bar[XB_XGEN(b.x)]) == gen, bar);
      __builtin_amdgcn_fence(__ATOMIC_ACQUIRE, "agent");
      asm volatile("s_waitcnt vmcnt(0)" ::: "memory");
    }
  }
  __syncthreads();
}

DI void ffn_phases(const P& p, XcdBarrier& xb, int layer, int s, int M, char* smem, int vb, int nvb) {
  char* ws = p.ws;
  {
    GemmDesc g = gemm_simple((const u16*)(ws + OFF_REGA), 1024, (const u16*)(ws + OFF_WGU) + (size_t)s * 5632 * 1024,
                             1024, M, 5632);
    g.o16 = (u16*)(ws + OFF_REGB); g.ldo = DFF;
    gemm_auto<EPI_SWIGLU>(g, M, smem, vb, nvb);
  }
  xcd_barrier(xb);
  {
    GemmDesc g = gemm_simple((const u16*)(ws + OFF_REGB), DFF, (const u16*)(ws + OFF_WDN) + (size_t)s * 1024 * 2816,
                             DFF, M, 1024);
    g.xres = p.out; g.hres = (float*)(ws + OFF_RH);
    g.mod = (const float*)(ws + OFF_MODS) + (size_t)layer * 9 * 9216;
    g.gidx = s == 0 ? 2 : 8; g.coef = 0.5f;
    gemm_auto<EPI_RES>(g, M, smem, vb, nvb);
  }
  xcd_barrier(xb);
}

__global__ void __launch_bounds__(NTHR, 2) mega(P p) {
  extern __shared__ __attribute__((aligned(16))) char smem[];
  cg::grid_group grid = cg::this_grid();
  const int vb = blockIdx.x, nvb = gridDim.x;
  char* ws = p.ws;
  XcdBarrier xb = xcd_barrier_post((unsigned*)(ws + OFF_BAR), gridDim.x, true);
  const bool subgrid = nvb >= 512;
  XcdBarrier xb2 = xcd_barrier_post((unsigned*)(ws + OFF_BAR) + 4096, gridDim.x - 256, subgrid && vb >= 256);
  if (p.ws == nullptr) grid.sync();

  mods_phase(p, smem, vb, nvb);
  __syncthreads();
  convert_weights(p, 0, smem, vb, nvb, 0);
  xcd_barrier(xb);

  for (int layer = 0; layer < 2; ++layer) {
    const bool ctx_out = layer == 0;
    if (layer == 1) convert_weights(p, 1, smem, vb, nvb, 0);
    normmod_phase(p, layer, 0, T, layer == 0, vb, nvb);
    xcd_barrier(xb);
    ffn_phases(p, xb, layer, 0, T, smem, vb, nvb);
    normmod_phase(p, layer, 1, T, false, vb, nvb);
    xcd_barrier(xb);
    {
      GemmDesc g = gemm_simple((const u16*)(ws + OFF_REGA), 1024, (const u16*)(ws + OFF_WIN), 1024, T,
                               layer == 0 ? EVEN_PAD : ODD_PAD);
      g.o16 = (u16*)(ws + OFF_REGB);
      g.ldo = layer == 0 ? EVEN_IN : ODD_IN;
      g.nreal = g.ldo;
      g.side = (float*)(ws + OFF_SIDE);
      g.slo = layer == 0 ? 2208 : 1024;
      gemm_auto<EPI_STORE>(g, T, smem, vb, nvb);
    }
    xcd_barrier(xb);
    if (layer == 0) {
      const bool split0 = subgrid;
      const int svb = split0 ? vb - 256 : vb, snvb = split0 ? nvb - 256 : nvb;
      if (!split0 || vb < 256)
        for (int cid = vb; cid < 256; cid += (split0 ? 256 : nvb)) gdn_chain(p, cid, smem);
      __syncthreads();
      if (!split0 || vb >= 256) {
        XcdBarrier& bs = split0 ? xb2 : xb;
        {
          GemmDesc g = gemm_simple((const u16*)(ws + OFF_REGB), EVEN_IN, (const u16*)(ws + OFF_WQUP), 384, T, 768);
          g.o16 = (u16*)(ws + OFF_QB); g.ldo = 768; g.nreal = 768;
          gemm_auto<EPI_STORE>(g, T, smem, svb, snvb);
          GemmDesc g2 = gemm_simple((const u16*)(ws + OFF_REGB) + 384, EVEN_IN, (const u16*)(ws + OFF_WKVUP), 256, T, 1024);
          g2.o16 = (u16*)(ws + OFF_REGA); g2.ldo = 1024; g2.nreal = 1024;
          gemm_auto<EPI_STORE>(g2, T, smem, svb, snvb);
        }
        xcd_barrier(bs);
        mla_finalize(p, smem, svb, snvb);
        xcd_barrier(bs);
        const u16* Q = (const u16*)(ws + OFF_QB);
        const u16* Kb = (const u16*)(ws + OFF_KB);
        const u16* KV = (const u16*)(ws + OFF_REGA);
        for (int it = svb; it < 1024 + 128; it += snvb) {
          if (it < 1024) {
            const int b = it >> 7, h = (it >> 4) & 7, qt = it & 15;
            attn_item<96, false>(Q, 768, h * 96, Kb, 768, h * 96, KV, 1024, h * 128 + 64, b * SEQ + qt * 128, qt * 128,
                                 LAT + b * CTXL, b * SEQ, 0, 32, 0.f, (u16*)(ws + OFF_QB), 768, h * 96, smem);
          } else {
            const int j = it - 1024;
            const int b = j >> 4, h = (j >> 1) & 7, qt = j & 1;
            attn_item<96, false>(Q, 768, h * 96, Kb, 768, h * 96, KV, 1024, h * 128 + 64, LAT + b * CTXL + qt * 128, 0,
                                 LAT + b * CTXL, b * SEQ, 0, 0, 0.f, (u16*)(ws + OFF_QB), 768, h * 96, smem);
          }
        }
        __syncthreads();
        convert_weights(p, 0, smem, svb, snvb, 1);
      }
      xcd_barrier(xb);
      scan_post(p, 0, vb, nvb);
      xcd_barrier(xb);
      {
        GemmDesc g = gemm_simple((const u16*)(ws + OFF_QB), 768, (const u16*)(ws + OFF_WOUT), 1024, T, 1024);
        g.kstep0 = 96; g.ksplit = 8; g.A1 = (const u16*)(ws + OFF_ODIR); g.lda1 = 512;
        g.xres = p.out; g.hres = (float*)(ws + OFF_RH);
        g.mod = (const float*)(ws + OFF_MODS); g.gidx = 5; g.coef = 1.f;
        gemm_auto<EPI_RES>(g, T, smem, vb, nvb);
      }
      xcd_barrier(xb);
    } else {
      swa_finalize(p, smem, vb, nvb);
      xcd_barrier(xb);
      const bool split1 = nvb >= 256;
      if (!split1 || vb < 128)
        for (int cid = vb; cid < 128; cid += (split1 ? 128 : nvb)) gla_chain_mfma(p, cid, smem);
      __syncthreads();
      if (!split1 || vb >= 128)
      {
        const u16* Q = (const u16*)(ws + OFF_QB);
        const u16* Kb = (const u16*)(ws + OFF_KB);
        const u16* z = (const u16*)(ws + OFF_REGB);
        for (int it = (split1 ? vb - 128 : vb); it < 1024; it += (split1 ? nvb - 128 : nvb)) {
          const int b = it >> 7, h = (it >> 4) & 7, qt = it & 15;
          const int g2 = h >> 2;
          const int q0 = qt * 128;
          const int lo = (q0 - 128 < 0 ? 0 : q0 - 128) >> 6;
          const int hi = (q0 + 256 > SEQ ? SEQ : q0 + 256) >> 6;
          attn_item<64, true>(Q, 512, h * 64, Kb, 128, g2 * 64, z, ODD_IN, 2208 + g2 * 64, b * SEQ + q0, q0,
                              LAT + b * CTXL, b * SEQ, lo, hi, p.od_sink[h] * LOG2E, (u16*)(ws + OFF_REGA), 512, h * 64,
                              smem);
        }
        __syncthreads();
        convert_weights(p, 1, smem, split1 ? vb - 128 : vb, split1 ? nvb - 128 : nvb, 1);
      }
      xcd_barrier(xb);
      scan_post(p, 1, vb, nvb);
      xcd_barrier(xb);
      {
        GemmDesc g = gemm_simple((const u16*)(ws + OFF_ODIR), 512, (const u16*)(ws + OFF_WOUT), 1024, LAT, 1024);
        g.kstep0 = 64; g.ksplit = 8; g.A1 = (const u16*)(ws + OFF_REGA); g.lda1 = 512;
        g.xres = p.out; g.hres = (float*)(ws + OFF_RH);
        g.mod = (const float*)(ws + OFF_MODS) + (size_t)9 * 9216; g.gidx = 5; g.coef = 1.f;
        gemm_auto<EPI_RES>(g, LAT, smem, vb, nvb);
      }
      xcd_barrier(xb);
    }
    const int M2 = ctx_out ? T : LAT;
    normmod_phase(p, layer, 2, M2, false, vb, nvb);
    xcd_barrier(xb);
    ffn_phases(p, xb, layer, 1, M2, smem, vb, nvb);
  }
}

extern "C" void kernel_launch(void* const* d_in, const int* in_sizes, int n_in, void* d_out, int out_size, void* d_ws,
                              size_t ws_size, hipStream_t stream) {
  static int grid_blocks = 0;
  if (!grid_blocks) {
    int dev = 0, cus = 0, per_cu = 0;
    hipGetDevice(&dev);
    hipDeviceGetAttribute(&cus, hipDeviceAttributeMultiprocessorCount, dev);
    hipFuncSetAttribute((const void*)mega, hipFuncAttributeMaxDynamicSharedMemorySize, SMEM_BYTES);
    hipOccupancyMaxActiveBlocksPerMultiprocessor(&per_cu, mega, NTHR, SMEM_BYTES);
    if (per_cu > 2) per_cu = 2;
    grid_blocks = cus * per_cu;
    if (ws_size < WS_NEED) fprintf(stderr, "workspace too small: %zu < %zu\n", ws_size, (size_t)WS_NEED);
  }
  P p{};
  const float* const* in = (const float* const*)d_in;
  p.x = in[0]; p.c = in[1]; p.ctx = in[2]; p.c_ctx = in[3]; p.ada_w = in[4]; p.ada_b = in[5]; p.norm_g = in[6];
  p.ffn_g = in[7]; p.ffn_u = in[8]; p.ffn_d = in[9];
  p.ev_w_in = in[10]; p.ev_q_a_norm = in[11]; p.ev_w_q_up = in[12]; p.ev_kv_a_norm = in[13]; p.ev_w_kv_up = in[14];
  p.ev_q_norm = in[15]; p.ev_k_norm = in[16]; p.ev_conv = in[17]; p.ev_a_log = in[18]; p.ev_dt_bias = in[19];
  p.ev_out_norm = in[20]; p.ev_w_out = in[21];
  p.od_w_in = in[22]; p.od_w2 = in[23]; p.od_gb = in[24]; p.od_out_norm = in[25]; p.od_q_norm = in[26];
  p.od_k_norm = in[27]; p.od_sink = in[28]; p.od_w_out = in[29];
  p.out = (float*)d_out;
  p.ws = (char*)d_ws;
  hipMemsetAsync((char*)d_ws + OFF_BAR, 0, 32768, stream);
  void* args[] = {&p};
  hipError_t e = hipLaunchCooperativeKernel((const void*)mega, dim3(grid_blocks), dim3(NTHR), args, SMEM_BYTES, stream);
  if (e != hipSuccess) fprintf(stderr, "cooperative launch failed: %s (grid %d)\n", hipGetErrorString(e), grid_blocks);
}
```
